# Optimizing an MI355X kernel written in HIP

```python
import math
import jax, jax.numpy as jnp
from jax import lax
import numpy as np

D_MODEL = 1024
BATCH = 8
SEQ = 2048
DEPTH = 4
DEC_BATCH = 128
DEC_SEQ = 1
PAST_LEN = 16384
PAGE_SIZE = 128

N_MIXERS = 3
N_S5 = (DEPTH + 2) // N_MIXERS
N_RWKV = (DEPTH + 1) // N_MIXERS
N_RGLRU = DEPTH // N_MIXERS
RMS_EPS = 1e-6

S5_GROUP = 16
S5_GROUPS = D_MODEL // S5_GROUP
S5_STATE = 64
S5_DT_MIN = 1e-3
S5_DT_MAX = 1e-1

RWKV_HEAD = 64
RWKV_HEADS = D_MODEL // RWKV_HEAD
RWKV_LORA_W = 64
RWKV_LORA_A = 64
RWKV_LORA_G = 128
RWKV_GN_EPS = 64e-5

D_RNN = D_MODEL
LRU_BLOCKS = 4
LRU_BLOCK = D_RNN // LRU_BLOCKS
LRU_C = 8.0
LRU_CONV = 4

D_FF = 2816
FFN_CONV = 3

kernel_name = 'hybrid_s5_rwkv7_rglru_convffn_step'


def rms_norm(x, g):
    xf = x.astype(jnp.float32)
    xf = xf * lax.rsqrt(jnp.mean(xf * xf, axis=-1, keepdims=True) + RMS_EPS)
    return (xf * g.astype(jnp.float32)).astype(x.dtype)


def causal_dwconv(u, buf, w, b):
    width = w.shape[0]
    length = u.shape[1]
    ext = jnp.concatenate([buf.astype(u.dtype), u], axis=1)
    out = b + ext[:, 0:length] * w[0]
    for k in range(1, width):
        out = out + ext[:, k:k + length] * w[k]
    return out, ext[:, ext.shape[1] - (width - 1):]


def _lin_combine(e1, e2):
    a1, b1 = e1
    a2, b2 = e2
    return a1 * a2, a2 * b1 + b2


def _cplx_combine(e1, e2):
    a1r, a1i, b1r, b1i = e1
    a2r, a2i, b2r, b2i = e2
    return (a2r * a1r - a2i * a1i, a2r * a1i + a2i * a1r,
            a2r * b1r - a2i * b1i + b2r, a2r * b1i + a2i * b1r + b2i)


def s5_mixer(u, h0_re, h0_im, p):
    f32 = jnp.float32
    bsz, length, _ = u.shape
    ug = u.astype(f32).reshape(bsz, length, S5_GROUPS, S5_GROUP)
    lam_re = jnp.minimum(p['s5_a_re'].astype(f32), -1e-4)
    lam_im = p['s5_a_im'].astype(f32)
    dt = jnp.exp(p['s5_log_dt'].astype(f32))[:, None]
    mag = jnp.exp(lam_re * dt)
    ab_re = mag * jnp.cos(lam_im * dt)
    ab_im = mag * jnp.sin(lam_im * dt)
    den = lam_re * lam_re + lam_im * lam_im
    coef_re = ((ab_re - 1.0) * lam_re + ab_im * lam_im) / den
    coef_im = (ab_im * lam_re - (ab_re - 1.0) * lam_im) / den
    bu_re = jnp.einsum('blgc,gpc->blgp', ug, p['s5_b_re'].astype(f32))
    bu_im = jnp.einsum('blgc,gpc->blgp', ug, p['s5_b_im'].astype(f32))
    x_re = coef_re * bu_re - coef_im * bu_im
    x_im = coef_re * bu_im + coef_im * bu_re
    h0r = h0_re.astype(f32)
    h0i = h0_im.astype(f32)
    x_re = x_re.at[:, 0].add(ab_re * h0r - ab_im * h0i)
    x_im = x_im.at[:, 0].add(ab_re * h0i + ab_im * h0r)
    shp = x_re.shape
    _, _, h_re, h_im = lax.associative_scan(
        _cplx_combine,
        (jnp.broadcast_to(ab_re, shp), jnp.broadcast_to(ab_im, shp), x_re, x_im), axis=1)
    y = (jnp.einsum('blgp,gcp->blgc', h_re, p['s5_c_re'].astype(f32))
         - jnp.einsum('blgp,gcp->blgc', h_im, p['s5_c_im'].astype(f32)))
    y = y.reshape(bsz, length, D_MODEL) + p['s5_d'].astype(f32) * u.astype(f32)
    z = jnp.einsum('bld,de->ble', jax.nn.gelu(y).astype(u.dtype), p['s5_w_glu'])
    val, gate = jnp.split(z, 2, axis=-1)
    return val * jax.nn.sigmoid(gate), h_re[:, -1], h_im[:, -1]


def rwkv7_mixer(x, shift0, s0, p):
    f32 = jnp.float32
    bsz, length, _ = x.shape
    prev = jnp.concatenate([shift0[:, None].astype(x.dtype), x[:, :-1]], axis=1)
    xx = prev - x
    xs = x[None] + xx[None] * p['rw_mu'][:, None, None, :]
    rkv = jnp.einsum('nbld,nde->nble', xs[:3], p['rw_w_rkv']).astype(f32)
    r, k, v = rkv[0], rkv[1], rkv[2]
    xw, xa, xg = xs[3], xs[4], xs[5]
    wlog = -jax.nn.softplus(-(p['rw_w0'] + jnp.tanh(xw @ p['rw_w1']) @ p['rw_w2']).astype(f32)) - 0.5
    decay = jnp.exp(-jnp.exp(wlog))
    a = jax.nn.sigmoid((p['rw_a0'] + (xa @ p['rw_a1']) @ p['rw_a2']).astype(f32))
    g = (jax.nn.sigmoid(xg @ p['rw_g1']) @ p['rw_g2']).astype(f32)
    heads = lambda t: t.reshape(bsz, length, RWKV_HEADS, RWKV_HEAD)
    kk = heads(k * p['rw_k_k'].astype(f32))
    kk = kk / jnp.maximum(jnp.sqrt(jnp.sum(kk * kk, axis=-1, keepdims=True)), 1e-12)
    k = k * (1.0 + (a - 1.0) * p['rw_k_a'].astype(f32))
    rh, dh, kh, vh, ah = heads(r), heads(decay), heads(k), heads(v), heads(a)

    def step(S, inp):
        r_t, w_t, k_t, v_t, kk_t, a_t = inp
        sa = jnp.einsum('bhij,bhj->bhi', S, -kk_t)
        S = (S * w_t[:, :, None, :] + sa[..., :, None] * (kk_t * a_t)[..., None, :]
             + v_t[..., :, None] * k_t[..., None, :])
        return S, jnp.einsum('bhij,bhj->bhi', S, r_t)

    seq = tuple(jnp.moveaxis(t, 1, 0) for t in (rh, dh, kh, vh, kk, ah))
    s_fin, o = lax.scan(step, s0.astype(f32), seq)
    o = jnp.moveaxis(o, 0, 1)
    mean = jnp.mean(o, axis=-1, keepdims=True)
    var = jnp.mean(jnp.square(o - mean), axis=-1, keepdims=True)
    o = ((o - mean) * lax.rsqrt(var + RWKV_GN_EPS)).reshape(bsz, length, D_MODEL)
    o = o * p['rw_ln_w'].astype(f32) + p['rw_ln_b'].astype(f32)
    bonus = jnp.sum(rh * kh * p['rw_r_k'].astype(f32), axis=-1, keepdims=True) * vh
    o = (o + bonus.reshape(bsz, length, D_MODEL)) * g
    out = jnp.einsum('bld,de->ble', o.astype(x.dtype), p['rw_w_o'])
    return out, x[:, -1], s_fin


def rglru_mixer(x, conv0, h0, p):
    f32 = jnp.float32
    bsz, length, _ = x.shape
    gy = jnp.einsum('bld,de->ble', x, p['lru_w_in'])
    gate_br, u = jnp.split(gy, 2, axis=-1)
    gate_br = jax.nn.gelu(gate_br.astype(f32))
    u, conv_new = causal_dwconv(u, conv0, p['lru_conv_w'], p['lru_conv_b'])
    ub = u.reshape(bsz, length, LRU_BLOCKS, LRU_BLOCK)
    rg = jax.nn.sigmoid((jnp.einsum('blnc,ncd->blnd', ub, p['lru_w_rg']).reshape(bsz, length, D_RNN)
                         + p['lru_b_rg']).astype(f32))
    ig = jax.nn.sigmoid((jnp.einsum('blnc,ncd->blnd', ub, p['lru_w_ig']).reshape(bsz, length, D_RNN)
                         + p['lru_b_ig']).astype(f32))
    log_a = LRU_C * rg * jax.nn.log_sigmoid(p['lru_lambda'].astype(f32))
    a = jnp.exp(log_a)
    mult = jnp.sqrt(-jnp.expm1(2.0 * log_a))
    bx = mult * ig * u.astype(f32)
    bx = bx.at[:, 0].add(a[:, 0] * h0.astype(f32))
    _, h = lax.associative_scan(_lin_combine, (a, bx), axis=1)
    out = jnp.einsum('ble,ed->bld', (h * gate_br).astype(x.dtype), p['lru_w_out'])
    return out, conv_new, h[:, -1]


def conv_ffn(x, conv0, w_in, conv_w, conv_b, w_out):
    hu = jnp.einsum('bld,df->blf', x, w_in)
    gate, up = jnp.split(hu, 2, axis=-1)
    gate, conv_new = causal_dwconv(gate, conv0, conv_w, conv_b)
    out = jnp.einsum('blf,fd->bld', jax.nn.silu(gate) * up, w_out)
    return out, conv_new


def _layer_slice(w, prefix, j):
    return {name: arr[j] for name, arr in w.items() if name.startswith(prefix)}


def trunk(x, st, w):
    dt = x.dtype
    out = {'s5_re': [], 's5_im': [], 'rw_wkv': [], 'rw_shift': [], 'lru_h': [], 'lru_conv': [], 'ffn_conv': []}
    for i in range(DEPTH):
        kind, j = i % N_MIXERS, i // N_MIXERS
        h = rms_norm(x, w['norm_mix'][i])
        if kind == 0:
            y, hr, hi = s5_mixer(h, st['s5_re'][j], st['s5_im'][j], _layer_slice(w, 's5_', j))
            out['s5_re'].append(hr)
            out['s5_im'].append(hi)
        elif kind == 1:
            y, sh, s = rwkv7_mixer(h, st['rw_shift'][j], st['rw_wkv'][j], _layer_slice(w, 'rw_', j))
            out['rw_shift'].append(sh)
            out['rw_wkv'].append(s)
        else:
            y, cb, hl = rglru_mixer(h, st['lru_conv'][j], st['lru_h'][j], _layer_slice(w, 'lru_', j))
            out['lru_conv'].append(cb)
            out['lru_h'].append(hl)
        x = x + y.astype(dt)
        h = rms_norm(x, w['norm_ffn'][i])
        y, cb = conv_ffn(h, st['ffn_conv'][i], w['ffn_w_in'][i], w['ffn_conv_w'][i],
                         w['ffn_conv_b'][i], w['ffn_w_out'][i])
        out['ffn_conv'].append(cb)
        x = x + y.astype(dt)
    y = rms_norm(x, w['norm_final'])
    new = {name: jnp.stack(v).astype(st[name].dtype) for name, v in out.items()}
    return y, new


def setup_inputs(seed: int = 0) -> dict:
    key = jax.random.key(seed)
    ks = iter(jax.random.split(key, 64))
    f32 = jnp.float32
    nrm = lambda shape, scale: scale * jax.random.normal(next(ks), shape, f32)
    unif = lambda shape, lo, hi: jax.random.uniform(next(ks), shape, f32, lo, hi)
    D = D_MODEL
    inp = {}
    inp['x_prompt'] = nrm((BATCH, SEQ, D), 1.0)
    inp['x_sample'] = nrm((DEC_BATCH, DEC_SEQ, D), 1.0)
    inp['state_s5_re'] = nrm((N_S5, DEC_BATCH, S5_GROUPS, S5_STATE), 0.1)
    inp['state_s5_im'] = nrm((N_S5, DEC_BATCH, S5_GROUPS, S5_STATE), 0.1)
    inp['state_rwkv_wkv'] = nrm((N_RWKV, DEC_BATCH, RWKV_HEADS, RWKV_HEAD, RWKV_HEAD), 0.1)
    inp['state_rwkv_shift'] = nrm((N_RWKV, DEC_BATCH, D), 1.0)
    inp['state_lru_h'] = nrm((N_RGLRU, DEC_BATCH, D_RNN), 0.5)
    inp['state_lru_conv'] = nrm((N_RGLRU, DEC_BATCH, LRU_CONV - 1, D_RNN), 1.0)
    inp['state_ffn_conv'] = nrm((DEPTH, DEC_BATCH, FFN_CONV - 1, D_FF), 1.0)
    inp['norm_mix'] = 1.0 + nrm((DEPTH, D), 0.02)
    inp['norm_ffn'] = 1.0 + nrm((DEPTH, D), 0.02)
    inp['norm_final'] = 1.0 + nrm((D,), 0.02)
    inp['s5_a_re'] = -0.5 + nrm((N_S5, S5_GROUPS, S5_STATE), 0.01)
    inp['s5_a_im'] = math.pi * jnp.arange(S5_STATE, dtype=f32) + nrm((N_S5, S5_GROUPS, S5_STATE), 0.01)
    inp['s5_log_dt'] = unif((N_S5, S5_GROUPS), math.log(S5_DT_MIN), math.log(S5_DT_MAX))
    inp['s5_b_re'] = nrm((N_S5, S5_GROUPS, S5_STATE, S5_GROUP), (2 * S5_GROUP) ** -0.5)
    inp['s5_b_im'] = nrm((N_S5, S5_GROUPS, S5_STATE, S5_GROUP), (2 * S5_GROUP) ** -0.5)
    inp['s5_c_re'] = nrm((N_S5, S5_GROUPS, S5_GROUP, S5_STATE), S5_STATE ** -0.5)
    inp['s5_c_im'] = nrm((N_S5, S5_GROUPS, S5_GROUP, S5_STATE), S5_STATE ** -0.5)
    inp['s5_d'] = nrm((N_S5, D), 1.0)
    inp['s5_w_glu'] = nrm((N_S5, D, 2 * D), D ** -0.5)
    inp['rw_mu'] = unif((N_RWKV, 6, D), 0.0, 1.0)
    inp['rw_w_rkv'] = nrm((N_RWKV, 3, D, D), D ** -0.5)
    inp['rw_w0'] = unif((N_RWKV, D), -6.0, 1.0)
    inp['rw_w1'] = nrm((N_RWKV, D, RWKV_LORA_W), D ** -0.5)
    inp['rw_w2'] = nrm((N_RWKV, RWKV_LORA_W, D), 0.5 * RWKV_LORA_W ** -0.5)
    inp['rw_a0'] = nrm((N_RWKV, D), 0.5)
    inp['rw_a1'] = nrm((N_RWKV, D, RWKV_LORA_A), D ** -0.5)
    inp['rw_a2'] = nrm((N_RWKV, RWKV_LORA_A, D), 0.5 * RWKV_LORA_A ** -0.5)
    inp['rw_g1'] = nrm((N_RWKV, D, RWKV_LORA_G), D ** -0.5)
    inp['rw_g2'] = nrm((N_RWKV, RWKV_LORA_G, D), RWKV_LORA_G ** -0.5)
    inp['rw_k_k'] = 0.85 + nrm((N_RWKV, D), 0.05)
    inp['rw_k_a'] = 1.0 + nrm((N_RWKV, D), 0.05)
    inp['rw_r_k'] = nrm((N_RWKV, RWKV_HEADS, RWKV_HEAD), 0.1)
    inp['rw_ln_w'] = 1.0 + nrm((N_RWKV, D), 0.02)
    inp['rw_ln_b'] = nrm((N_RWKV, D), 0.02)
    inp['rw_w_o'] = nrm((N_RWKV, D, D), D ** -0.5)
    inp['lru_w_in'] = nrm((N_RGLRU, D, 2 * D_RNN), D ** -0.5)
    inp['lru_conv_w'] = nrm((N_RGLRU, LRU_CONV, D_RNN), LRU_CONV ** -0.5)
    inp['lru_conv_b'] = nrm((N_RGLRU, D_RNN), 0.02)
    inp['lru_w_rg'] = nrm((N_RGLRU, LRU_BLOCKS, LRU_BLOCK, LRU_BLOCK), LRU_BLOCK ** -0.5)
    inp['lru_b_rg'] = nrm((N_RGLRU, D_RNN), 0.02)
    inp['lru_w_ig'] = nrm((N_RGLRU, LRU_BLOCKS, LRU_BLOCK, LRU_BLOCK), LRU_BLOCK ** -0.5)
    inp['lru_b_ig'] = nrm((N_RGLRU, D_RNN), 0.02)
    s = unif((N_RGLRU, D_RNN), 0.9, 0.999) ** (1.0 / LRU_C)
    inp['lru_lambda'] = jnp.log(s) - jnp.log1p(-s)
    inp['lru_w_out'] = nrm((N_RGLRU, D_RNN, D), D_RNN ** -0.5)
    inp['ffn_w_in'] = nrm((DEPTH, D, 2 * D_FF), D ** -0.5)
    inp['ffn_conv_w'] = nrm((DEPTH, FFN_CONV, D_FF), FFN_CONV ** -0.5)
    inp['ffn_conv_b'] = nrm((DEPTH, D_FF), 0.02)
    inp['ffn_w_out'] = nrm((DEPTH, D_FF, D), D_FF ** -0.5)
    return inp


def reference(x_prompt, x_sample, state_s5_re, state_s5_im, state_rwkv_wkv, state_rwkv_shift,
              state_lru_h, state_lru_conv, state_ffn_conv, norm_mix, norm_ffn, norm_final,
              s5_a_re, s5_a_im, s5_log_dt, s5_b_re, s5_b_im, s5_c_re, s5_c_im, s5_d, s5_w_glu,
              rw_mu, rw_w_rkv, rw_w0, rw_w1, rw_w2, rw_a0, rw_a1, rw_a2, rw_g1, rw_g2, rw_k_k,
              rw_k_a, rw_r_k, rw_ln_w, rw_ln_b, rw_w_o, lru_w_in, lru_conv_w, lru_conv_b,
              lru_w_rg, lru_b_rg, lru_w_ig, lru_b_ig, lru_lambda, lru_w_out, ffn_w_in,
              ffn_conv_w, ffn_conv_b, ffn_w_out):
    w = {'norm_mix': norm_mix, 'norm_ffn': norm_ffn, 'norm_final': norm_final,
         's5_a_re': s5_a_re, 's5_a_im': s5_a_im, 's5_log_dt': s5_log_dt, 's5_b_re': s5_b_re,
         's5_b_im': s5_b_im, 's5_c_re': s5_c_re, 's5_c_im': s5_c_im, 's5_d': s5_d, 's5_w_glu': s5_w_glu,
         'rw_mu': rw_mu, 'rw_w_rkv': rw_w_rkv, 'rw_w0': rw_w0, 'rw_w1': rw_w1, 'rw_w2': rw_w2,
         'rw_a0': rw_a0, 'rw_a1': rw_a1, 'rw_a2': rw_a2, 'rw_g1': rw_g1, 'rw_g2': rw_g2,
         'rw_k_k': rw_k_k, 'rw_k_a': rw_k_a, 'rw_r_k': rw_r_k, 'rw_ln_w': rw_ln_w, 'rw_ln_b': rw_ln_b,
         'rw_w_o': rw_w_o, 'lru_w_in': lru_w_in, 'lru_conv_w': lru_conv_w, 'lru_conv_b': lru_conv_b,
         'lru_w_rg': lru_w_rg, 'lru_b_rg': lru_b_rg, 'lru_w_ig': lru_w_ig, 'lru_b_ig': lru_b_ig,
         'lru_lambda': lru_lambda, 'lru_w_out': lru_w_out, 'ffn_w_in': ffn_w_in,
         'ffn_conv_w': ffn_conv_w, 'ffn_conv_b': ffn_conv_b, 'ffn_w_out': ffn_w_out}
    bsz, dt = x_prompt.shape[0], x_prompt.dtype
    st_prompt = {'s5_re': jnp.zeros((N_S5, bsz, S5_GROUPS, S5_STATE), dt),
                 's5_im': jnp.zeros((N_S5, bsz, S5_GROUPS, S5_STATE), dt),
                 'rw_wkv': jnp.zeros((N_RWKV, bsz, RWKV_HEADS, RWKV_HEAD, RWKV_HEAD), dt),
                 'rw_shift': jnp.zeros((N_RWKV, bsz, D_MODEL), dt),
                 'lru_h': jnp.zeros((N_RGLRU, bsz, D_RNN), dt),
                 'lru_conv': jnp.zeros((N_RGLRU, bsz, LRU_CONV - 1, D_RNN), dt),
                 'ffn_conv': jnp.zeros((DEPTH, bsz, FFN_CONV - 1, D_FF), dt)}
    st_sample = {'s5_re': state_s5_re, 's5_im': state_s5_im, 'rw_wkv': state_rwkv_wkv,
                 'rw_shift': state_rwkv_shift, 'lru_h': state_lru_h, 'lru_conv': state_lru_conv,
                 'ffn_conv': state_ffn_conv}
    y_prompt, new_p = trunk(x_prompt, st_prompt, w)
    y_sample, new_s = trunk(x_sample, st_sample, w)
    return (y_prompt, y_sample, new_p['s5_re'], new_s['s5_re'], new_p['s5_im'], new_s['s5_im'],
            new_p['rw_wkv'], new_s['rw_wkv'], new_p['rw_shift'], new_s['rw_shift'],
            new_p['lru_h'], new_s['lru_h'], new_p['lru_conv'], new_s['lru_conv'],
            new_p['ffn_conv'], new_s['ffn_conv'])
```

```cpp
#include <hip/hip_runtime.h>
#include <hip/hip_cooperative_groups.h>
#include <cstdio>
#include <cstdint>
namespace cg = cooperative_groups;

#define PROBE_SYNC2 0
#define PROBE_PH 0
#define REP(bit) for (int rp_ = 0; rp_ < ((PROBE_PH & (bit)) ? 2 : 1); ++rp_)
#define PROBE_GEMM2 0
#define PROBE_RW4 0
#define PROBE_EW2 0
#define PROBE_PRO2 0
#define PROBE_CONV2 0
#define PROBE_MISC2 0
#define PROBE_GEN2 0
#define PROBE_SG2 0
#define PROBE_EPI2 0
#ifndef PER_PHASE_LAUNCH
#define PER_PHASE_LAUNCH 0
#endif

#define LAS __attribute__((address_space(3)))
typedef unsigned short bf16_t;
typedef short bf16x8 __attribute__((ext_vector_type(8)));
typedef float f32x4 __attribute__((ext_vector_type(4)));
typedef float f32x2 __attribute__((ext_vector_type(2)));
typedef float f32x16 __attribute__((ext_vector_type(16)));
typedef unsigned u32x4 __attribute__((ext_vector_type(4)));
typedef unsigned u32x2 __attribute__((ext_vector_type(2)));

constexpr int D = 1024, LSEQ = 2048, NB = 8, MP = NB * LSEQ, MS = 128, MA = MP + MS, FF = 2816;
constexpr float RMS_EPS = 1e-6f;
constexpr size_t O_Y = 0;
constexpr size_t O_S5RE_P = (size_t)MA * D;
constexpr size_t O_S5RE_S = O_S5RE_P + 2 * 8 * 4096;
constexpr size_t O_S5IM_P = O_S5RE_S + 2 * 128 * 4096;
constexpr size_t O_S5IM_S = O_S5IM_P + 2 * 8 * 4096;
constexpr size_t O_WKV_P = O_S5IM_S + 2 * 128 * 4096;
constexpr size_t O_WKV_S = O_WKV_P + 8 * 16 * 4096;
constexpr size_t O_SH_P = O_WKV_S + (size_t)128 * 16 * 4096;
constexpr size_t O_SH_S = O_SH_P + 8 * 1024;
constexpr size_t O_LH_P = O_SH_S + 128 * 1024;
constexpr size_t O_LH_S = O_LH_P + 8 * 1024;
constexpr size_t O_LC_P = O_LH_S + 128 * 1024;
constexpr size_t O_LC_S = O_LC_P + 8 * 3 * 1024;
constexpr size_t O_FC_P = O_LC_S + 128 * 3 * 1024;
constexpr size_t O_FC_S = O_FC_P + 4 * 8 * 2 * FF;
constexpr size_t O_END = O_FC_S + (size_t)4 * 128 * 2 * FF;
static_assert(O_END == 31809536, "output size");

constexpr size_t MiB = 1u << 20;
constexpr size_t WS_WGLU = 0, WS_WFIN = 8 * MiB, WS_WFOUT = 52 * MiB, WS_WRW2 = 74 * MiB, WS_WRW3 = 87 * MiB, WS_WRWO = 89 * MiB,
                 WS_WLIN = 91 * MiB, WS_WRGIG = 95 * MiB, WS_WLOUT = 96 * MiB, WS_TBL = 98 * MiB, WS_LSL = 98 * MiB + 512 * 1024,
                 WS_CAR = 99 * MiB, WS_CTL = 101 * MiB, WS_XB = 102 * MiB, WS_SSQ = 135 * MiB, WS_AR = 138 * MiB, WS_END = WS_AR + 204 * MiB;
constexpr size_t AR_G = 0, AR_UP = 89 * MiB;
constexpr size_t AR_A2 = 0, AR_HLOC = 48 * MiB, AR_YB = 80 * MiB;
constexpr size_t AR_S5A = 180 * MiB, AR_S5C = 188 * MiB;
constexpr size_t AR_HX = 0, AR_DEC = 0, AR_AA = 32 * MiB + 512 * 1024, AR_RKV = 65 * MiB, RKV_PLANE = 32 * MiB + 512 * 1024,
                 AR_LORA = AR_RKV + 3 * RKV_PLANE, AR_GG = AR_LORA + 8 * MiB + 512 * 1024;
constexpr size_t AR_GATE = 0, AR_UPRE = 32 * MiB + 512 * 1024, AR_U = 65 * MiB, AR_AF = 97 * MiB + 512 * 1024,
                 AR_BX = 162 * MiB + 512 * 1024;
static_assert(AR_GG + 32 * MiB + 512 * 1024 <= 204 * MiB && AR_BX + 32 * MiB + 512 * 1024 <= 204 * MiB, "arena");

__device__ __forceinline__ int otid() { int t = threadIdx.x; asm volatile("" : "+v"(t)); return t; }
__device__ __forceinline__ int obid() { int t = blockIdx.x; asm volatile("" : "+s"(t)); return t; }

__device__ __forceinline__ unsigned f2bf(float f) { unsigned u = __builtin_bit_cast(unsigned, f); return (u + 0x7fffu + ((u >> 16) & 1u)) >> 16; }
__device__ __forceinline__ unsigned pk2(float lo, float hi) { return f2bf(lo) | (f2bf(hi) << 16); }
__device__ __forceinline__ float bflo(unsigned w) { return __uint_as_float(w << 16); }
__device__ __forceinline__ float bfhi(unsigned w) { return __uint_as_float(w & 0xffff0000u); }
__device__ __forceinline__ float bf1(bf16_t b) { return __uint_as_float((unsigned)b << 16); }
__device__ __forceinline__ u32x2 pk4(f32x4 v) { u32x2 r; r.x = pk2(v[0], v[1]); r.y = pk2(v[2], v[3]); return r; }
__device__ __forceinline__ f32x4 unpk4(u32x2 w) { return (f32x4){bflo(w.x), bfhi(w.x), bflo(w.y), bfhi(w.y)}; }
__device__ __forceinline__ float sigmoidf_(float x) { return 1.f / (1.f + __expf(-x)); }
__device__ __forceinline__ float gelu_tanh(float x) { const float z = 0.7978845608f * (x + 0.044715f * x * x * x); return x / (1.f + __expf(-2.f * z)); }
__device__ __forceinline__ float tanhf_(float x) { return 1.f - 2.f / (__expf(2.f * x) + 1.f); }
__device__ __forceinline__ float wave_sum(float v) {
#pragma unroll
    for (int o = 1; o < 64; o <<= 1) v += __shfl_xor(v, o);
    return v;
}
template <int CTRL> __device__ __forceinline__ float dppf(float x) {
    return __builtin_bit_cast(float, __builtin_amdgcn_update_dpp(0, __builtin_bit_cast(int, x), CTRL, 0xf, 0xf, true));
}
__device__ __forceinline__ float row16_sum(float x) {
    x += dppf<0xB1>(x);
    x += dppf<0x4E>(x);
    x += dppf<0x141>(x);
    x += dppf<0x140>(x);
    return x;
}

namespace pg8 {
constexpr int BM = 256, BK = 64, HALF = 128, HTB = HALF * BK * 2, STAGE_BYTES = 8 * HTB, NXCD = 8, WGM = 8;
__host__ __device__ __forceinline__ int lds_byte(int r, int c) { const int st = (r >> 4) * 2 + (c >> 5), rr = r & 15, cc = c & 31, ob = rr * 64 + cc * 2; return st * 1024 + (ob ^ (((ob >> 9) & 1) << 5)); }
__host__ __device__ __forceinline__ void stage_rc(int b, int& R, int& C) { const int st = b / 1024, sb = b % 1024, swz = sb ^ (((sb >> 9) & 1) << 5); R = (st >> 1) * 16 + swz / 64; C = (st & 1) * 32 + (swz % 64) / 2; }
__host__ __device__ __forceinline__ int perm32(int rho) { const int n = rho >> 4, i = rho & 15; return 8 * (i >> 2) + 4 * n + (i & 3); }

struct Unit { int pm, pn; };
struct Gemm { const bf16_t* A; const bf16_t* Bt; int lda, ldb, K, nM, nN; int a_ndiv; int a_nstride; int b_mdiv; int b_mstride; };
__device__ __forceinline__ const char* a_base(const Gemm& g, const Unit& u) { return (const char*)(g.A + (size_t)u.pm * 256 * g.lda + (size_t)(u.pn / g.a_ndiv) * g.a_nstride); }
__device__ __forceinline__ const char* b_base(const Gemm& g, const Unit& u) { return (const char*)(g.Bt + (size_t)u.pn * 256 * g.ldb + (size_t)(u.pm / g.b_mdiv) * g.b_mstride); }

struct StaticOrder {
    int nM, nN, nwg, G, c;
    __device__ void init(int nM_, int nN_, int G_, int c_) { nM = nM_; nN = nN_; nwg = nM * nN; G = G_; c = c_; }
    __device__ bool next(int i, Unit& u) const {
        const long L = (long)i * G + c; if (L >= nwg) return false;
        int wgid = (int)L; { const int q = nwg / NXCD, r = nwg % NXCD, xcd = wgid % NXCD, off = wgid / NXCD; wgid = (xcd < r ? xcd * (q + 1) : r * (q + 1) + (xcd - r) * q) + off; }
        const int nig = WGM * nN, gid = wgid / nig, fm = gid * WGM, gsz = (nM - fm) < WGM ? (nM - fm) : WGM;
        u.pm = fm + ((wgid % nig) % gsz); u.pn = (wgid % nig) / gsz; return true;
    }
};

template <class Epi>
__device__ __forceinline__ void gemm_phase(LAS unsigned char* lds, const Gemm g, const StaticOrder& S, const Epi& E) {
    const int tid = otid(), wid = __builtin_amdgcn_readfirstlane(tid >> 6), lane = tid & 63, wr = wid >> 2, wc = wid & 3, fr = lane & 15, fq = lane >> 4;
    const int K = g.K, nt = K / BK;
    unsigned voffA[2], voffB[2];
#pragma unroll
    for (int i = 0; i < 2; ++i) { int R, C; stage_rc(tid * 16 + i * 8192, R, C); const int Rb = (R & ~31) + perm32(R & 31);
        voffA[i] = (unsigned)(R * g.lda + C) * 2u; voffB[i] = (unsigned)(Rb * g.ldb + C) * 2u; }
    const size_t kstep = (size_t)(BK * 2);
    const size_t hstepA = (size_t)HALF * g.lda * 2, hstepB = (size_t)HALF * g.ldb * 2;
    const unsigned ldsw = (unsigned)wid * 1024u;
    const int aoff = lds_byte(wr * 64 + fr, fq * 8), boff = lds_byte(wc * 32 + fr, fq * 8);
#define PG8_SA(b, h) (((b) * 2 + (h)) * HTB)
#define PG8_SB(b, h) ((4 + (b) * 2 + (h)) * HTB)
#define PG8_STAGE(bufoff, gbase, voff) do { _Pragma("unroll") for (int _i = 0; _i < 2; ++_i) \
        __builtin_amdgcn_global_load_lds((const unsigned*)((const char*)(gbase) + (voff)[_i]), (LAS unsigned*)(lds + (bufoff) + ldsw + _i * 8192), 16, 0, 0); } while (0)
#define PG8_LDA(dst, b, h) do { _Pragma("unroll") for (int m = 0; m < 4; ++m) _Pragma("unroll") for (int k = 0; k < 2; ++k) dst[m][k] = *(const LAS bf16x8*)(lds + PG8_SA(b, h) + aoff + m * 2048 + k * 1024); } while (0)
#define PG8_LDB(dst, b, h) do { _Pragma("unroll") for (int n = 0; n < 2; ++n) _Pragma("unroll") for (int k = 0; k < 2; ++k) dst[n][k] = *(const LAS bf16x8*)(lds + PG8_SB(b, h) + boff + n * 2048 + k * 1024); } while (0)
#define PG8_MMA(ai, bj, At, Bt) do { __builtin_amdgcn_s_setprio(1); _Pragma("unroll") for (int m = 0; m < 4; ++m) _Pragma("unroll") for (int n = 0; n < 2; ++n) _Pragma("unroll") for (int k = 0; k < 2; ++k) \
        acc[ai][bj][m][n] = __builtin_amdgcn_mfma_f32_16x16x32_bf16(Bt[n][k], At[m][k], acc[ai][bj][m][n], 0, 0, 0); __builtin_amdgcn_s_setprio(0); } while (0)
#define PG8_WAIT_V(n) asm volatile("s_waitcnt vmcnt(" #n ")" ::: "memory")
#define PG8_WAIT_L(n) asm volatile("s_waitcnt lgkmcnt(" #n ")" ::: "memory")
#define PG8_BAR __builtin_amdgcn_s_barrier()
#define PG8_SCHED __builtin_amdgcn_sched_barrier(0)
    Unit cur, nxt; int ui = 0;
    if (!S.next(0, cur)) return;
    f32x4 acc[2][2][4][2];
#pragma unroll
    for (int a = 0; a < 2; ++a)
#pragma unroll
        for (int b = 0; b < 2; ++b)
#pragma unroll
            for (int m = 0; m < 4; ++m)
#pragma unroll
                for (int n = 0; n < 2; ++n) acc[a][b][m][n] = (f32x4){0.f, 0.f, 0.f, 0.f};
    bf16x8 At[4][2], B0[2][2], B1[2][2];
    const char* cA = a_base(g, cur); const char* cB = b_base(g, cur);
    PG8_STAGE(PG8_SB(0, 0), cB, voffB); PG8_STAGE(PG8_SB(0, 1), cB + hstepB, voffB); PG8_STAGE(PG8_SA(0, 0), cA, voffA); PG8_STAGE(PG8_SA(0, 1), cA + hstepA, voffA);
    if (wr == 1) PG8_BAR;
    PG8_WAIT_V(2); PG8_BAR;
    PG8_STAGE(PG8_SB(1, 0), cB + kstep, voffB); PG8_STAGE(PG8_SA(1, 0), cA + kstep, voffA); PG8_STAGE(PG8_SB(1, 1), cB + hstepB + kstep, voffB);
    PG8_WAIT_V(6); PG8_BAR;
    for (;;) {
        const bool has_next = S.next(ui + 1, nxt);
        const char* nA = has_next ? a_base(g, nxt) : cA; const char* nB = has_next ? b_base(g, nxt) : cB;
        for (int t = 0; t < nt; t += 2) {
            const bool last = (t == nt - 2);
            const char* a1 = cA + (size_t)(t + 1) * kstep;
            const char* a2 = last ? nA : cA + (size_t)(t + 2) * kstep; const char* b2 = last ? nB : cB + (size_t)(t + 2) * kstep;
            const char* a3 = a2 + kstep; const char* b3 = b2 + kstep;
            PG8_LDB(B0, 0, 0); PG8_LDB(B1, 0, 1); PG8_SCHED; PG8_LDA(At, 0, 0); PG8_STAGE(PG8_SA(1, 1), a1 + hstepA, voffA);
            PG8_WAIT_V(8); PG8_WAIT_L(0); PG8_BAR; PG8_MMA(0, 0, At, B0); PG8_MMA(0, 1, At, B1); PG8_BAR; PG8_SCHED;
            PG8_LDA(At, 0, 1); PG8_STAGE(PG8_SB(0, 0), b2, voffB); PG8_STAGE(PG8_SB(0, 1), b2 + hstepB, voffB); PG8_STAGE(PG8_SA(0, 0), a2, voffA);
            PG8_WAIT_V(8); PG8_WAIT_L(0); PG8_BAR; PG8_MMA(1, 0, At, B0); PG8_MMA(1, 1, At, B1); PG8_BAR; PG8_SCHED;
            PG8_LDB(B0, 1, 0); PG8_LDB(B1, 1, 1); PG8_SCHED; PG8_LDA(At, 1, 0); PG8_STAGE(PG8_SA(0, 1), a2 + hstepA, voffA);
            PG8_WAIT_V(8); PG8_WAIT_L(0); PG8_BAR; PG8_MMA(0, 0, At, B0); PG8_MMA(0, 1, At, B1); PG8_BAR; PG8_SCHED;
            PG8_LDA(At, 1, 1); PG8_STAGE(PG8_SB(1, 0), b3, voffB); PG8_STAGE(PG8_SB(1, 1), b3 + hstepB, voffB); PG8_STAGE(PG8_SA(1, 0), a3, voffA);
            PG8_WAIT_V(8); PG8_WAIT_L(0); PG8_BAR; PG8_MMA(1, 0, At, B0); PG8_MMA(1, 1, At, B1); PG8_BAR; PG8_SCHED;
        }
        if (wr == 0) PG8_BAR;
        E(acc, cur, wr, wc, fr, fq);
        if (PROBE_EPI2 && Epi::IDEMP) E(acc, cur, wr, wc, fr, fq);
        if (!has_next) break;
#pragma unroll
        for (int a = 0; a < 2; ++a)
#pragma unroll
            for (int b = 0; b < 2; ++b)
#pragma unroll
                for (int m = 0; m < 4; ++m)
#pragma unroll
                    for (int n = 0; n < 2; ++n) acc[a][b][m][n] = (f32x4){0.f, 0.f, 0.f, 0.f};
        cur = nxt; cA = nA; cB = nB; ++ui;
        if (wr == 1) PG8_BAR;
    }
    PG8_WAIT_V(0);
    PG8_BAR;
#undef PG8_SA
#undef PG8_SB
#undef PG8_STAGE
#undef PG8_LDA
#undef PG8_LDB
#undef PG8_MMA
#undef PG8_WAIT_V
#undef PG8_WAIT_L
#undef PG8_BAR
#undef PG8_SCHED
}
}

__device__ __forceinline__ float rstd_from(float s) { return 1.f / sqrtf(s * (1.f / D) + RMS_EPS); }

struct NoPre {};
template <class F> struct EpiWrap {
    static constexpr bool IDEMP = !F::HAS_SSQ;
    F f; const float* ssq_in; float* ssq_out;
    __device__ __forceinline__ void operator()(const f32x4 (&acc)[2][2][4][2], const pg8::Unit& u, int wr, int wc, int fr, int fq) const {
        const f32x4 z = {0.f, 0.f, 0.f, 0.f};
        constexpr int NCG = F::PAIRED ? 1 : 2;
        int colg[NCG]; typename F::CP cp[NCG];
#pragma unroll
        for (int c = 0; c < NCG; ++c) { colg[c] = F::PAIRED ? u.pn * 128 + wc * 32 + fq * 8 : u.pn * 256 + c * 128 + wc * 32 + fq * 8; cp[c] = f.cpre(u.pm * 256, colg[c]); }
#pragma unroll
        for (int ai = 0; ai < 2; ++ai) {
            typename F::RP rp[4][NCG]; f32x4 sa[4], sb[4];
#pragma unroll
            for (int m = 0; m < 4; ++m) {
                const int row = u.pm * 256 + ai * 128 + wr * 64 + m * 16 + fr;
                if (F::NEED_RSTD) { sa[m] = *(const f32x4*)(ssq_in + (size_t)row * 32 + fq * 8); sb[m] = *(const f32x4*)(ssq_in + (size_t)row * 32 + fq * 8 + 4); }
#pragma unroll
                for (int c = 0; c < NCG; ++c) rp[m][c] = f.rpre(row, colg[c]);
            }
#pragma unroll
            for (int m = 0; m < 4; ++m) {
                const int row = u.pm * 256 + ai * 128 + wr * 64 + m * 16 + fr;
                float rs = 1.f;
                if (F::NEED_RSTD) { float s = (sa[m][0] + sa[m][1]) + (sa[m][2] + sa[m][3]) + (sb[m][0] + sb[m][1]) + (sb[m][2] + sb[m][3]); s += __shfl_xor(s, 16); s += __shfl_xor(s, 32); rs = rstd_from(s); }
                if (F::PAIRED) {
                    float q = f.fin(row, colg[0], acc[ai][0][m][0], acc[ai][0][m][1], acc[ai][1][m][0], acc[ai][1][m][1], rs, cp[0], rp[m][0]);
                    if (F::HAS_SSQ) { q += __shfl_xor(q, 16); q += __shfl_xor(q, 32); if (fq == 0) ssq_out[(size_t)row * 32 + u.pn * 4 + wc] = q; }
                } else {
#pragma unroll
                    for (int bj = 0; bj < 2; ++bj) {
                        float q = f.fin(row, colg[bj], acc[ai][bj][m][0], acc[ai][bj][m][1], z, z, rs, cp[bj], rp[m][bj]);
                        if (F::HAS_SSQ) { q += __shfl_xor(q, 16); q += __shfl_xor(q, 32); if (fq == 0) ssq_out[(size_t)row * 32 + u.pn * 8 + bj * 4 + wc] = q; }
                    }
                }
            }
        }
    }
};
__device__ __forceinline__ u32x4 pk8(f32x4 a, f32x4 b) { u32x4 r; r.x = pk2(a[0], a[1]); r.y = pk2(a[2], a[3]); r.z = pk2(b[0], b[1]); r.w = pk2(b[2], b[3]); return r; }
__device__ __forceinline__ float ssq4(f32x4 x) { return (x[0] * x[0] + x[1] * x[1]) + (x[2] * x[2] + x[3] * x[3]); }
#define UNPK8(WW_, lo, hi) const f32x4 lo = {bflo((WW_)[0]), bfhi((WW_)[0]), bflo((WW_)[1]), bfhi((WW_)[1])}, hi = {bflo((WW_)[2]), bfhi((WW_)[2]), bflo((WW_)[3]), bfhi((WW_)[3])}
struct X8 { f32x4 x0, x1; };
struct U8 { u32x4 w; };
struct C24 { f32x4 a0, a1, b0, b1, c0, c1; };

struct F_RES {
    static constexpr bool PAIRED = false, NEED_RSTD = false, HAS_SSQ = true;
    typedef NoPre CP; typedef X8 RP;
    float* X; bf16_t* XB; bool dry = false;
    __device__ __forceinline__ CP cpre(int, int) const { return CP{}; }
    __device__ __forceinline__ RP rpre(int row, int col) const { const float* xp = X + (size_t)row * D + col; return RP{*(const f32x4*)xp, *(const f32x4*)(xp + 4)}; }
    __device__ __forceinline__ float fin(int row, int col, f32x4 a0, f32x4 a1, f32x4, f32x4, float, const CP&, const RP& r) const {
        float* xp = X + (size_t)row * D + col; const f32x4 x0 = r.x0 + a0, x1 = r.x1 + a1; *(f32x4*)xp = dry ? r.x0 : x0; *(f32x4*)(xp + 4) = dry ? r.x1 : x1;
        *(u32x4*)(XB + (size_t)row * D + col) = pk8(x0, x1); return ssq4(x0) + ssq4(x1);
    }
};
struct F_GLU {
    static constexpr bool PAIRED = true, NEED_RSTD = false, HAS_SSQ = true;
    typedef NoPre CP; typedef X8 RP;
    float* X; bf16_t* XB; bool dry = false; const float* Xp = nullptr; const float* Xs = nullptr;
    __device__ __forceinline__ CP cpre(int, int) const { return CP{}; }
    __device__ __forceinline__ RP rpre(int row, int col) const { const float* xp = (row < MP ? Xp + (size_t)row * D : Xs + (size_t)(row - MP) * D) + col; return RP{*(const f32x4*)xp, *(const f32x4*)(xp + 4)}; }
    __device__ __forceinline__ float fin(int row, int col, f32x4 a0, f32x4 a1, f32x4 b0, f32x4 b1, float, const CP&, const RP& r) const {
        float* xp = X + (size_t)row * D + col; f32x4 x0 = r.x0, x1 = r.x1;
#pragma unroll
        for (int e = 0; e < 4; ++e) { x0[e] += a0[e] * sigmoidf_(b0[e]); x1[e] += a1[e] * sigmoidf_(b1[e]); }
        *(f32x4*)xp = dry ? r.x0 : x0; *(f32x4*)(xp + 4) = dry ? r.x1 : x1; *(u32x4*)(XB + (size_t)row * D + col) = pk8(x0, x1); return ssq4(x0) + ssq4(x1);
    }
};
struct F_FFNIN {
    static constexpr bool PAIRED = true, NEED_RSTD = true, HAS_SSQ = false;
    typedef NoPre CP; typedef NoPre RP;
    bf16_t* G; bf16_t* UP;
    __device__ __forceinline__ CP cpre(int, int) const { return CP{}; }
    __device__ __forceinline__ RP rpre(int, int) const { return RP{}; }
    __device__ __forceinline__ float fin(int row, int col, f32x4 a0, f32x4 a1, f32x4 b0, f32x4 b1, float rs, const CP&, const RP&) const {
        *(u32x4*)(G + (size_t)row * FF + col) = pk8(a0 * rs, a1 * rs); *(u32x4*)(UP + (size_t)row * FF + col) = pk8(b0 * rs, b1 * rs); return 0.f;
    }
};
struct F_LRUIN {
    static constexpr bool PAIRED = true, NEED_RSTD = true, HAS_SSQ = false;
    typedef NoPre CP; typedef NoPre RP;
    bf16_t* GATEp; bf16_t* UPREp;
    __device__ __forceinline__ CP cpre(int, int) const { return CP{}; }
    __device__ __forceinline__ RP rpre(int, int) const { return RP{}; }
    __device__ __forceinline__ float fin(int row, int col, f32x4 a0, f32x4 a1, f32x4 b0, f32x4 b1, float rs, const CP&, const RP&) const {
        f32x4 g0, g1;
#pragma unroll
        for (int e = 0; e < 4; ++e) { g0[e] = gelu_tanh(a0[e] * rs); g1[e] = gelu_tanh(a1[e] * rs); }
        *(u32x4*)(GATEp + (size_t)row * D + col) = pk8(g0, g1); *(u32x4*)(UPREp + (size_t)row * D + col) = pk8(b0 * rs, b1 * rs); return 0.f;
    }
};
struct F_RGIG {
    static constexpr bool PAIRED = true, NEED_RSTD = false, HAS_SSQ = false;
    typedef C24 CP; typedef U8 RP;
    const float* brg; const float* big; const float* lsl; const bf16_t* U; float* AF; bf16_t* BX;
    __device__ __forceinline__ CP cpre(int, int col) const { return CP{*(const f32x4*)(brg + col), *(const f32x4*)(brg + col + 4), *(const f32x4*)(big + col), *(const f32x4*)(big + col + 4), *(const f32x4*)(lsl + col), *(const f32x4*)(lsl + col + 4)}; }
    __device__ __forceinline__ RP rpre(int row, int col) const { return RP{*(const u32x4*)(U + (size_t)row * D + col)}; }
    __device__ __forceinline__ void half(f32x4 b0, f32x4 b1, f32x4 ls, f32x4 v0, f32x4 v1, f32x4 uu, f32x4& a, f32x4& bx) const {
#pragma unroll
        for (int e = 0; e < 4; ++e) { const float rg = sigmoidf_(v0[e] + b0[e]), ig = sigmoidf_(v1[e] + b1[e]); const float la = rg * ls[e];
            a[e] = __expf(la); const float m2 = 1.f - __expf(2.f * la); bx[e] = sqrtf(m2 > 0.f ? m2 : 0.f) * ig * uu[e]; }
    }
    __device__ __forceinline__ float fin(int row, int col, f32x4 a0, f32x4 a1, f32x4 b0, f32x4 b1, float, const CP& c, const RP& r) const {
        UNPK8(r.w, u0, u1); f32x4 r0, r1, x0, x1;
        half(c.a0, c.b0, c.c0, a0, b0, u0, r0, x0); half(c.a1, c.b1, c.c1, a1, b1, u1, r1, x1);
        *(f32x4*)(AF + (size_t)row * D + col) = r0; *(f32x4*)(AF + (size_t)row * D + col + 4) = r1; *(u32x4*)(BX + (size_t)row * D + col) = pk8(x0, x1); return 0.f;
    }
};
struct F_RW2 {
    static constexpr bool PAIRED = false, NEED_RSTD = false, HAS_SSQ = false;
    typedef NoPre CP; typedef NoPre RP;
    bf16_t* RKVp; bf16_t* LORAp;
    __device__ __forceinline__ CP cpre(int, int) const { return CP{}; }
    __device__ __forceinline__ RP rpre(int, int) const { return RP{}; }
    __device__ __forceinline__ float fin(int row, int col, f32x4 a0, f32x4 a1, f32x4, f32x4, float, const CP&, const RP&) const {
        if (col < 3072) { const int j = col >> 10, c = col & 1023; *(u32x4*)(RKVp + (size_t)j * (RKV_PLANE / 2) + (size_t)row * D + c) = pk8(a0, a1); }
        else { const int c = col - 3072; f32x4 o0, o1;
#pragma unroll
            for (int e = 0; e < 4; ++e) { o0[e] = c < 64 ? tanhf_(a0[e]) : (c < 128 ? a0[e] : sigmoidf_(a0[e])); o1[e] = c < 64 ? tanhf_(a1[e]) : (c < 128 ? a1[e] : sigmoidf_(a1[e])); }
            *(u32x4*)(LORAp + (size_t)row * 256 + c) = pk8(o0, o1); }
        return 0.f;
    }
};
struct F_RW3 {
    static constexpr bool PAIRED = false, NEED_RSTD = false, HAS_SSQ = false;
    typedef X8 CP; typedef NoPre RP;
    const float* w0; const float* a0p; bf16_t* DEC; bf16_t* AA; bf16_t* GG;
    __device__ __forceinline__ CP cpre(int, int col) const { const int j = col >> 10, c = col & 1023; const float* p = j == 0 ? w0 + c : a0p + c; if (j == 2) p = w0; return CP{*(const f32x4*)p, *(const f32x4*)(p + 4)}; }
    __device__ __forceinline__ RP rpre(int, int) const { return RP{}; }
    __device__ __forceinline__ f32x4 dec4(f32x4 w, f32x4 v) const { f32x4 o;
#pragma unroll
        for (int e = 0; e < 4; ++e) { const float z = w[e] + v[e]; const float wl = -__logf(1.f + __expf(-z)) - 0.5f; const float ew = __expf(wl); o[e] = ew < 1e-3f ? ew * (1.f - 0.5f * ew) : 1.f - __expf(-ew); }
        return o; }
    __device__ __forceinline__ f32x4 sig4(f32x4 w, f32x4 v) const { f32x4 o;
#pragma unroll
        for (int e = 0; e < 4; ++e) o[e] = sigmoidf_(w[e] + v[e]);
        return o; }
    __device__ __forceinline__ float fin(int row, int col, f32x4 a0, f32x4 a1, f32x4, f32x4, float, const CP& cp, const RP&) const {
        const int j = col >> 10, c = col & 1023;
        if (j == 0) *(u32x4*)(DEC + (size_t)row * D + c) = pk8(dec4(cp.x0, a0), dec4(cp.x1, a1));
        else if (j == 1) *(u32x4*)(AA + (size_t)row * D + c) = pk8(sig4(cp.x0, a0), sig4(cp.x1, a1));
        else *(u32x4*)(GG + (size_t)row * D + c) = pk8(a0, a1);
        return 0.f;
    }
};
struct F_S5A {
    static constexpr bool PAIRED = false, NEED_RSTD = false, HAS_SSQ = false;
    typedef NoPre CP; typedef NoPre RP;
    float* HLOC;
    __device__ __forceinline__ CP cpre(int, int) const { return CP{}; }
    __device__ __forceinline__ RP rpre(int, int) const { return RP{}; }
    __device__ __forceinline__ float fin(int row, int col, f32x4 a0, f32x4 a1, f32x4, f32x4, float, const CP&, const RP&) const {
        if (col < 128) { *(f32x4*)(HLOC + (size_t)row * 128 + col) = a0; *(f32x4*)(HLOC + (size_t)row * 128 + col + 4) = a1; } return 0.f; }
};
struct F_S5C {
    static constexpr bool PAIRED = false, NEED_RSTD = false, HAS_SSQ = false;
    typedef X8 CP; typedef U8 RP;
    const bf16_t* A2p; const float* dsk; bf16_t* YBp;
    __device__ __forceinline__ CP cpre(int row0, int col) const { const int ch = (row0 >> 10) * 16 + (col & 15); return CP{*(const f32x4*)(dsk + ch), *(const f32x4*)(dsk + ch + 4)}; }
    __device__ __forceinline__ RP rpre(int row, int col) const { return RP{*(const u32x4*)(A2p + (size_t)row * 384 + col)}; }
    __device__ __forceinline__ float fin(int row, int col, f32x4 a0, f32x4 a1, f32x4, f32x4, float, const CP& cp, const RP& r) const {
        const int g = row >> 10, b = (row >> 7) & 7, j = row & 127, s = col >> 4, c = col & 15, tok = b * LSEQ + j * 16 + s, ch = g * 16 + c;
        UNPK8(r.w, u0, u1); f32x4 o0, o1;
#pragma unroll
        for (int e = 0; e < 4; ++e) { o0[e] = gelu_tanh(a0[e] + cp.x0[e] * u0[e]); o1[e] = gelu_tanh(a1[e] + cp.x1[e] * u1[e]); }
        *(u32x4*)(YBp + (size_t)tok * D + ch) = pk8(o0, o1); return 0.f;
    }
};


template <int CTRL> __device__ __forceinline__ float dpp_mov(float x) { return __builtin_bit_cast(float, __builtin_amdgcn_mov_dpp(__builtin_bit_cast(int, x), CTRL, 0xf, 0xf, true)); }
template <int CTRL> __device__ __forceinline__ float dpp_shr_old(float old, float x) { return __builtin_bit_cast(float, __builtin_amdgcn_update_dpp(__builtin_bit_cast(int, old), __builtin_bit_cast(int, x), CTRL, 0xf, 0xf, false)); }
struct EpiFFN {
    static constexpr bool IDEMP = false;
    bf16_t* ACT; float* HALO; float* GFIX; float* UPFIX; const float* ssq_in; const float* cw; const float* cb; float* fcp; LAS float* xch;
    __device__ __forceinline__ void operator()(f32x4 (&acc)[2][2][4][2], const pg8::Unit& u, int wr, int wc, int fr, int fq) const {
        const int colg = u.pn * 128 + wc * 32 + fq * 8, pm = u.pm;
        const int tix = ((wr * 4 + wc) * 4 + fq) * 16 + fr, twhich = tix >> 7, tcol = tix & 127, rrow = tix >> 1, rh = tix & 1;
        const float* sp = ssq_in + (size_t)(pm * 256 + rrow) * 32 + rh * 16;
        const f32x4 s0 = *(const f32x4*)sp, s1 = *(const f32x4*)(sp + 4), s2 = *(const f32x4*)(sp + 8), s3 = *(const f32x4*)(sp + 12);
        const float tval = twhich < 3 ? cw[(size_t)twhich * FF + u.pn * 128 + tcol] : cb[u.pn * 128 + tcol];
        LAS float* wtab = xch + 1024; LAS float* rtab = xch + 1536;
        { const f32x4 t = (s0 + s1) + (s2 + s3); float sm = (t[0] + t[1]) + (t[2] + t[3]); sm += __shfl_xor(sm, 1); if (rh == 0) rtab[rrow] = rstd_from(sm); }
        wtab[tix] = tval;
        asm volatile("s_waitcnt lgkmcnt(0)" ::: "memory"); __builtin_amdgcn_s_barrier(); asm volatile("" ::: "memory");
#pragma unroll
        for (int ai = 0; ai < 2; ++ai)
#pragma unroll
            for (int m = 0; m < 4; ++m) { const float rs = rtab[ai * 128 + wr * 64 + m * 16 + fr];
#pragma unroll
                for (int n = 0; n < 2; ++n) { acc[ai][0][m][n] *= rs; acc[ai][1][m][n] *= rs; } }
        if (fr >= 14) {
#pragma unroll
            for (int ai = 0; ai < 2; ++ai)
#pragma unroll
                for (int n = 0; n < 2; ++n) *(LAS f32x4*)(xch + (((((ai * 2 + wr) * 4 + wc) * 2 + (fr - 14)) * 4 + fq) * 8 + n * 4)) = acc[ai][0][3][n];
            if (wr == 1) {
#pragma unroll
                for (int n = 0; n < 2; ++n) { *(f32x4*)(HALO + (size_t)(pm * 2 + fr - 14) * FF + colg + 4 * n) = acc[1][0][3][n];
                    if ((pm & 7) == 7) *(f32x4*)(fcp + (size_t)((pm >> 3) * 2 + fr - 14) * FF + colg + 4 * n) = acc[1][0][3][n]; }
            }
        }
        if (wr == 0 && fr < 2) {
#pragma unroll
            for (int n = 0; n < 2; ++n) { *(f32x4*)(GFIX + (size_t)(pm * 2 + fr) * FF + colg + 4 * n) = acc[0][0][0][n]; *(f32x4*)(UPFIX + (size_t)(pm * 2 + fr) * FF + colg + 4 * n) = acc[0][1][0][n]; }
        }
        asm volatile("s_waitcnt lgkmcnt(0)" ::: "memory"); __builtin_amdgcn_s_barrier(); asm volatile("" ::: "memory");
        f32x4 w0[2], w1[2], w2[2], bb[2];
#pragma unroll
        for (int n = 0; n < 2; ++n) { const int lc = wc * 32 + fq * 8 + 4 * n; w0[n] = *(const LAS f32x4*)(wtab + lc); w1[n] = *(const LAS f32x4*)(wtab + 128 + lc); w2[n] = *(const LAS f32x4*)(wtab + 256 + lc); bb[n] = *(const LAS f32x4*)(wtab + 384 + lc); }
#pragma unroll
        for (int ai = 0; ai < 2; ++ai) {
            f32x4 prev[2];
            if (ai == 0 && wr == 0) { prev[0] = (f32x4){0.f, 0.f, 0.f, 0.f}; prev[1] = prev[0]; }
            else { const int sbk = wr == 1 ? ai * 2 : (ai - 1) * 2 + 1;
#pragma unroll
                for (int n = 0; n < 2; ++n) prev[n] = *(const LAS f32x4*)(xch + ((((sbk * 4 + wc) * 2 + (fr & 1)) * 4 + fq) * 8 + n * 4)); }
#pragma unroll
            for (int m = 0; m < 4; ++m) {
                const int row = pm * 256 + ai * 128 + wr * 64 + m * 16 + fr; f32x4 o[2];
#pragma unroll
                for (int n = 0; n < 2; ++n) {
                    const f32x4 gc = acc[ai][0][m][n], gp = m == 0 ? prev[n] : acc[ai][0][m - 1][n], up = acc[ai][1][m][n];
#pragma unroll
                    for (int e = 0; e < 4; ++e) {
                        const float x1 = dpp_shr_old<0x111>(dpp_mov<0x121>(gp[e]), gc[e]), x2 = dpp_shr_old<0x112>(dpp_mov<0x122>(gp[e]), gc[e]);
                        const float c = bb[n][e] + x2 * w0[n][e] + x1 * w1[n][e] + gc[e] * w2[n][e];
                        o[n][e] = c * sigmoidf_(c) * up[e];
                    }
                }
                *(u32x4*)(ACT + (size_t)row * FF + colg) = pk8(o[0], o[1]);
            }
        }
    }
};
struct F_FFNIN_S {
    static constexpr bool PAIRED = true, NEED_RSTD = true, HAS_SSQ = false;
    typedef NoPre CP; typedef NoPre RP;
    bf16_t* ACT; const float* st; float* so; const float* cw; const float* cb;
    __device__ __forceinline__ CP cpre(int, int) const { return CP{}; }
    __device__ __forceinline__ RP rpre(int, int) const { return RP{}; }
    __device__ __forceinline__ float fin(int row, int col, f32x4 a0, f32x4 a1, f32x4 b0, f32x4 b1, float rs, const CP&, const RP&) const {
        const int bs = row - MP; f32x4 o[2];
#pragma unroll
        for (int n = 0; n < 2; ++n) { const int c = col + 4 * n; const f32x4 g = (n ? a1 : a0) * rs, up = (n ? b1 : b0) * rs;
            const f32x4 x0 = *(const f32x4*)(st + (size_t)(bs * 2) * FF + c), x1 = *(const f32x4*)(st + (size_t)(bs * 2 + 1) * FF + c);
            *(f32x4*)(so + (size_t)(bs * 2) * FF + c) = x1; *(f32x4*)(so + (size_t)(bs * 2 + 1) * FF + c) = g;
            const f32x4 cv = *(const f32x4*)(cb + c) + x0 * *(const f32x4*)(cw + c) + x1 * *(const f32x4*)(cw + FF + c) + g * *(const f32x4*)(cw + 2 * FF + c);
#pragma unroll
            for (int e = 0; e < 4; ++e) o[n][e] = cv[e] * sigmoidf_(cv[e]) * up[e]; }
        *(u32x4*)(ACT + (size_t)row * FF + col) = pk8(o[0], o[1]); return 0.f;
    }
};

struct F_NULL1 { static constexpr bool PAIRED = false, NEED_RSTD = false, HAS_SSQ = false; typedef NoPre CP; typedef NoPre RP; float* sink;
    __device__ __forceinline__ CP cpre(int, int) const { return CP{}; }
    __device__ __forceinline__ RP rpre(int, int) const { return RP{}; }
    __device__ __forceinline__ float fin(int row, int col, f32x4 v0, f32x4 v1, f32x4, f32x4, float, const CP&, const RP&) const { if (v0[0] == 12345.678f) sink[0] = v0[1] + v0[2] + v0[3] + v1[0]; return 0.f; } };
struct F_NULL2 { static constexpr bool PAIRED = true, NEED_RSTD = false, HAS_SSQ = false; typedef NoPre CP; typedef NoPre RP; float* sink;
    __device__ __forceinline__ CP cpre(int, int) const { return CP{}; }
    __device__ __forceinline__ RP rpre(int, int) const { return RP{}; }
    __device__ __forceinline__ float fin(int row, int col, f32x4 v0, f32x4 v1, f32x4 w0, f32x4 w1, float, const CP&, const RP&) const { if (v0[0] == 12345.678f) sink[0] = v0[1] + v1[2] + w0[3] + w1[0]; return 0.f; } };
template <class F>
__device__ __forceinline__ void sample_gemm_(LAS unsigned char* lds, const bf16_t* A, int lda, const bf16_t* Bt, int ldb, int ncb, int K, int row_base,
                                            const F& f, const float* ssq_in, float* ssq_out, int a_cb_div, int a_cb_stride, int wg0) {
    const int tid = otid(), wid = tid >> 6, lane = tid & 63, r32 = lane & 31, kq = lane >> 5;
    LAS float* red = (LAS float*)lds;
    const int ks = K / 16, k0 = wid * ks / 8, k1 = (wid + 1) * ks / 8;
    const int nwg_ = (int)gridDim.x - wg0;
    for (int tile = obid() - wg0; tile >= 0 && tile < 4 * ncb; tile += nwg_) {
        const int rb = tile & 3, cb = tile >> 2;
        const int brow0 = F::PAIRED ? ((cb >> 2) * 256 + (cb & 3) * 32) : cb * 32;
        const bf16_t* ap = A + (size_t)(rb * 32 + r32) * lda + kq * 8 + (cb / a_cb_div) * a_cb_stride;
        const bf16_t* bp = Bt + (size_t)(brow0 + r32) * ldb + kq * 8;
        f32x16 acc0, acc1;
#pragma unroll
        for (int i = 0; i < 16; ++i) { acc0[i] = 0.f; acc1[i] = 0.f; }
        constexpr int NBT = F::PAIRED ? 8 : 11;
        for (int k = k0; k < k1; k += NBT) {
            bf16x8 av[NBT], bv[NBT], cv[NBT];
#pragma unroll
            for (int i = 0; i < NBT; ++i) if (k + i < k1) { av[i] = *(const bf16x8*)(ap + (k + i) * 16); bv[i] = *(const bf16x8*)(bp + (k + i) * 16); if (F::PAIRED) cv[i] = *(const bf16x8*)(bp + (size_t)128 * ldb + (k + i) * 16); }
#pragma unroll
            for (int i = 0; i < NBT; ++i) if (k + i < k1) { acc0 = __builtin_amdgcn_mfma_f32_32x32x16_bf16(av[i], bv[i], acc0, 0, 0, 0); if (F::PAIRED) acc1 = __builtin_amdgcn_mfma_f32_32x32x16_bf16(av[i], cv[i], acc1, 0, 0, 0); }
        }
#pragma unroll
        for (int r = 0; r < 16; ++r) { const int rw = (r & 3) + 8 * (r >> 2) + 4 * kq;
            red[(wid * 32 + rw) * 33 + r32] = acc0[r]; if (F::PAIRED) red[8448 + (wid * 32 + rw) * 33 + r32] = acc1[r]; }
        __syncthreads();
        if (tid < 128) {
            const int row = tid >> 2, c8 = (tid & 3) * 8, grow = row_base + rb * 32 + row;
            f32x4 v0 = {0.f, 0.f, 0.f, 0.f}, v1 = v0, w0 = v0, w1 = v0;
#pragma unroll
            for (int w = 0; w < 8; ++w)
#pragma unroll
                for (int e = 0; e < 4; ++e) { v0[e] += red[(w * 32 + row) * 33 + c8 + e]; v1[e] += red[(w * 32 + row) * 33 + c8 + 4 + e];
                    if (F::PAIRED) { w0[e] += red[8448 + (w * 32 + row) * 33 + c8 + e]; w1[e] += red[8448 + (w * 32 + row) * 33 + c8 + 4 + e]; } }
            float rs = 1.f;
            if (F::NEED_RSTD) { const f32x4 a = *(const f32x4*)(ssq_in + (size_t)grow * 32 + (tid & 3) * 8), b = *(const f32x4*)(ssq_in + (size_t)grow * 32 + (tid & 3) * 8 + 4);
                float s = (a[0] + a[1]) + (a[2] + a[3]) + (b[0] + b[1]) + (b[2] + b[3]); s += __shfl_xor(s, 1); s += __shfl_xor(s, 2); rs = rstd_from(s); }
            const typename F::CP cp_ = f.cpre(grow, cb * 32 + c8); const typename F::RP rp_ = f.rpre(grow, cb * 32 + c8);
            float q = f.fin(grow, cb * 32 + c8, v0, v1, w0, w1, rs, cp_, rp_);
            if (F::HAS_SSQ) { q += __shfl_xor(q, 1); q += __shfl_xor(q, 2); if ((tid & 3) == 0) ssq_out[(size_t)grow * 32 + cb] = q; }
        }
        __syncthreads();
    }
}

template <class F>
__device__ __forceinline__ void sample_gemm(LAS unsigned char* lds, const bf16_t* A, int lda, const bf16_t* Bt, int ldb, int ncb, int K, int row_base,
                                            const F& f, const float* ssq_in, float* ssq_out, int a_cb_div = 1 << 30, int a_cb_stride = 0, int wg0 = 0) {
    if (wg0 >= (int)gridDim.x) wg0 = 0;
    if (PROBE_SG2) { if (F::PAIRED) { F_NULL2 n{ssq_out ? ssq_out : (float*)ssq_in}; sample_gemm_(lds, A, lda, Bt, ldb, ncb, K, row_base, n, nullptr, nullptr, a_cb_div, a_cb_stride, wg0); }
                     else { F_NULL1 n{ssq_out ? ssq_out : (float*)ssq_in}; sample_gemm_(lds, A, lda, Bt, ldb, ncb, K, row_base, n, nullptr, nullptr, a_cb_div, a_cb_stride, wg0); } }
    sample_gemm_(lds, A, lda, Bt, ldb, ncb, K, row_base, f, ssq_in, ssq_out, a_cb_div, a_cb_stride, wg0);
}
struct Args { const float* in[50]; float* out; unsigned char* ws; int lo, hi; };
enum { I_XP = 0, I_XS, I_S5RE, I_S5IM, I_WKV, I_SHIFT, I_LH, I_LC, I_FC, I_NMIX, I_NFFN, I_NFIN, I_S5ARE, I_S5AIM, I_S5LDT, I_S5BRE, I_S5BIM, I_S5CRE, I_S5CIM,
       I_S5D, I_S5GLU, I_RWMU, I_RWRKV, I_RWW0, I_RWW1, I_RWW2, I_RWA0, I_RWA1, I_RWA2, I_RWG1, I_RWG2, I_RWKK, I_RWKA, I_RWRK, I_RWLNW, I_RWLNB, I_RWWO,
       I_LWIN, I_LCW, I_LCB, I_LWRG, I_LBRG, I_LWIG, I_LBIG, I_LLAM, I_LWOUT, I_FWIN, I_FCW, I_FCB, I_FWOUT };
typedef const __attribute__((address_space(4))) Args& ArgsR;
typedef const __attribute__((address_space(4))) Args* ArgsP;
__device__ __forceinline__ ArgsP opaque_args() { ArgsP p = (ArgsP)__builtin_amdgcn_kernarg_segment_ptr(); asm volatile("" : "+s"(p)); return p; }
#define WSB(off) ((bf16_t*)(a.ws + (off)))
#define WSF(off) ((float*)(a.ws + (off)))
#define NTHR 512

__device__ __forceinline__ void tr_item(const float* W, int ldw, const float* ks, bf16_t* dst, int dst_ld, int k0, int n0, int drow0, int dk0, LAS float* scr, int lane) {
    float v[32];
    const float* wp = W + (size_t)(k0 + (lane >> 5)) * ldw + n0 + (lane & 31);
#pragma unroll
    for (int i = 0; i < 32; ++i) v[i] = wp[(size_t)(2 * i) * ldw];
    if (ks) {
#pragma unroll
        for (int i = 0; i < 32; ++i) v[i] *= ks[k0 + 2 * i + (lane >> 5)];
    }
#pragma unroll
    for (int i = 0; i < 32; ++i) scr[(2 * i + (lane >> 5)) * 33 + (lane & 31)] = v[i];
    asm volatile("s_waitcnt lgkmcnt(0)" ::: "memory");
    const int c = lane & 7;
#pragma unroll
    for (int j = 0; j < 4; ++j) { const int n = (lane >> 3) + 8 * j; const LAS float* s = scr + (8 * c) * 33 + n;
        u32x4 o; o.x = pk2(s[0 * 33], s[1 * 33]); o.y = pk2(s[2 * 33], s[3 * 33]); o.z = pk2(s[4 * 33], s[5 * 33]); o.w = pk2(s[6 * 33], s[7 * 33]);
        *(u32x4*)(dst + (size_t)(drow0 + n) * dst_ld + dk0 + k0 + 8 * c) = o; }
    asm volatile("s_waitcnt lgkmcnt(0)" ::: "memory");
}

__device__ __forceinline__ void convert_items(ArgsR a, LAS unsigned char* lds, int gw, int NGW, int which) {
    const int tid = otid(), lane = tid & 63, wave = tid >> 6;
    LAS float* scr = (LAS float*)(lds + wave * 16384);
    const int total = which == 0 ? 14336 : 10240;
#pragma nounroll
    for (int q = gw; q < total; q += NGW) {
        int fit;
        if (which == 0) fit = q < 7680 ? q : (q < 10496 ? 13312 + (q - 7680) : 18944 + (q - 10496));
        else fit = q < 5632 ? 7680 + q : (q < 8448 ? 16128 + (q - 5632) : 22784 + (q - 8448));
        int job, it;
        if (fit < 2048) { job = fit >> 10; it = fit & 1023; }
        else if (fit < 13312) { const int q = fit - 2048; job = 2 + q / 2816; it = q % 2816; }
        else if (fit < 18944) { const int q = fit - 13312; job = 6 + q / 1408; it = q % 1408; }
        else if (fit < 22016) { const int q = fit - 18944; job = 10 + (q >> 9); it = q & 511; }
        else if (fit < 22272) { const int q = fit - 22016; if (q < 128) { job = 16 + (q >> 5); it = q & 31; } else { job = 20 + ((q - 128) >> 6); it = (q - 128) & 63; } }
        else if (fit < 22784) { job = 22; it = fit - 22272; }
        else if (fit < 23808) { job = 23; it = fit - 22784; }
        else if (fit < 24064) { const int q = fit - 23808; job = 24 + (q >> 5); it = q & 31; }
        else { job = 32; it = fit - 24064; }
        const float* src; const float* ks = nullptr; bf16_t* dst; int ldw, K, N, dst_ld, dk0 = 0, H = 0, row_off = 0;
        if (job < 2) { src = a.in[I_S5GLU] + (size_t)job * 1024 * 2048; ldw = 2048; K = 1024; N = 2048; dst = WSB(WS_WGLU) + (size_t)job * 2048 * 1024; dst_ld = 1024; H = 1024; }
        else if (job < 6) { const int i = job - 2; src = a.in[I_FWIN] + (size_t)i * 1024 * 5632; ldw = 5632; K = 1024; N = 5632; ks = a.in[I_NFFN] + i * 1024; dst = WSB(WS_WFIN) + (size_t)i * 5632 * 1024; dst_ld = 1024; H = 2816; }
        else if (job < 10) { const int i = job - 6; src = a.in[I_FWOUT] + (size_t)i * 2816 * 1024; ldw = 1024; K = 2816; N = 1024; dst = WSB(WS_WFOUT) + (size_t)i * 1024 * 2816; dst_ld = 2816; }
        else if (job < 16) { const int q = job - 10, j = q >> 1, hf = q & 1; src = a.in[I_RWRKV] + (size_t)j * 1024 * 1024; ldw = 1024; K = 1024; N = 1024; if (hf) ks = a.in[I_RWMU] + j * 1024;
            dst = WSB(WS_WRW2); dst_ld = 2048; dk0 = hf * 1024; row_off = j * 1024; }
        else if (job < 22) { const int q = job - 16, m = q >> 1, hf = q & 1; src = m == 0 ? a.in[I_RWW1] : (m == 1 ? a.in[I_RWA1] : a.in[I_RWG1]); N = m == 2 ? 128 : 64; ldw = N; K = 1024;
            if (hf) ks = a.in[I_RWMU] + (3 + m) * 1024; dst = WSB(WS_WRW2); dst_ld = 2048; dk0 = hf * 1024; row_off = 3072 + m * 64; }
        else if (job == 22) { src = a.in[I_RWWO]; ldw = 1024; K = 1024; N = 1024; dst = WSB(WS_WRWO); dst_ld = 1024; }
        else if (job == 23) { src = a.in[I_LWIN]; ldw = 2048; K = 1024; N = 2048; ks = a.in[I_NMIX] + 2 * 1024; dst = WSB(WS_WLIN); dst_ld = 1024; H = 1024; }
        else if (job < 32) { const int q = job - 24, kind = q >> 2, nb = q & 3; src = (kind ? a.in[I_LWIG] : a.in[I_LWRG]) + (size_t)nb * 65536; ldw = 256; K = 256; N = 256;
            dst = WSB(WS_WRGIG); dst_ld = 256; H = 256; row_off = nb * 512 + kind * 128; }
        else { src = a.in[I_LWOUT]; ldw = 1024; K = 1024; N = 1024; dst = WSB(WS_WLOUT); dst_ld = 1024; }
        (void)K;
        const int nblk = N / 32;
        {
            const int kb = it / nblk, nbk = it % nblk, n0 = nbk * 32;
            int drow0;
            if (H) { const int nr = n0 % H, kind = n0 / H; drow0 = row_off + (nr >> 7) * 256 + kind * 128 + (nr & 127); } else drow0 = row_off + n0;
            tr_item(src, ldw, ks, dst, dst_ld, kb * 64, n0, drow0, dk0, scr, lane);
        }
    }
}
__device__ __forceinline__ void prologue_weights(ArgsR a, LAS unsigned char* lds) {
    const int tid = otid(), lane = tid & 63, wave = tid >> 6;
    const int gw = obid() * 8 + wave, NGW = gridDim.x * 8;
    convert_items(a, lds, gw, NGW, 0);
    const int gt = obid() * NTHR + tid, NGT = gridDim.x * NTHR;
    for (int it = gt; it < 3072 * 32; it += NGT) {
        const int n = it >> 5, k8 = (it & 31) * 8, j = n >> 10, c = n & 1023; float v[8];
#pragma unroll
        for (int e = 0; e < 8; ++e) { const int k = k8 + e; float x = 0.f;
            if (j == 0) { if (k < 64) x = a.in[I_RWW2][(size_t)k * 1024 + c]; }
            else if (j == 1) { if (k >= 64 && k < 128) x = a.in[I_RWA2][(size_t)(k - 64) * 1024 + c]; }
            else { if (k >= 128) x = a.in[I_RWG2][(size_t)(k - 128) * 1024 + c]; }
            v[e] = x; }
        u32x4 o; o.x = pk2(v[0], v[1]); o.y = pk2(v[2], v[3]); o.z = pk2(v[4], v[5]); o.w = pk2(v[6], v[7]);
        *(u32x4*)(WSB(WS_WRW3) + (size_t)n * 256 + k8) = o;
    }
    for (int c = gt; c < 1024; c += NGT) { const float lam = a.in[I_LLAM][c]; WSF(WS_LSL)[c] = -8.f * log1pf(__expf(-lam)); }
    for (int row0 = gw; row0 < MA; row0 += 4 * NGW) {
        f32x4 xv[4][4]; int rws[4];
#pragma unroll
        for (int u = 0; u < 4; ++u) { const int row = row0 + u * NGW < MA ? row0 + u * NGW : row0; rws[u] = row;
            const float* xr = row < MP ? a.in[I_XP] + (size_t)row * D : a.in[I_XS] + (size_t)(row - MP) * D;
#pragma unroll
            for (int q = 0; q < 4; ++q) xv[u][q] = *(const f32x4*)(xr + lane * 4 + 256 * q); }
        float sv[4];
#pragma unroll
        for (int u = 0; u < 4; ++u) { float t = 0.f;
#pragma unroll
            for (int q = 0; q < 4; ++q) { const f32x4 v = xv[u][q]; t += (v[0] * v[0] + v[1] * v[1]) + (v[2] * v[2] + v[3] * v[3]); }
            sv[u] = t; }
#pragma unroll
        for (int o = 1; o < 64; o <<= 1) {
#pragma unroll
            for (int u = 0; u < 4; ++u) sv[u] += __shfl_xor(sv[u], o); }
#pragma unroll
        for (int u = 0; u < 4; ++u) if (lane < 32 && (u == 0 || row0 + u * NGW < MA)) WSF(WS_SSQ)[(size_t)rws[u] * 32 + lane] = lane == 0 ? sv[u] : 0.f;
    }
}

__device__ const double s5_kc[12] = {1.0 / 24, 1.0 / 720, 1.0 / 40320, 1.0 / 3628800, 1.0 / 479001600, 1.0 / 6, 1.0 / 120, 1.0 / 5040, 1.0 / 362880, 1.0 / 39916800, 1.0 / 6227020800.0, 0.0};
__device__ __forceinline__ void s5_gen(ArgsR a, LAS unsigned char* lds, int j) {
    const int tid = otid();
    LAS float* abp = (LAS float*)lds;
    LAS float* cB = abp + 17 * 128;
    LAS float* Cc = cB + 2048;
    LAS float* Kt = Cc + 2048;
    for (int g4 = obid(); g4 < 256; g4 += gridDim.x) {
        const int g = g4 >> 2, part = g4 & 3;
        __syncthreads();
        if (tid < 64) {
            const int p = tid, idx = (j * 64 + g) * 64 + p;
            const double lr = (double)fminf(a.in[I_S5ARE][idx], -1e-4f), li = (double)a.in[I_S5AIM][idx], dt = exp((double)a.in[I_S5LDT][j * 64 + g]);
            const double mag = exp(lr * dt); double ang = li * dt * 0.15915494309189535; ang -= rint(ang); const double th = ang * 6.283185307179586 * 0.125;
            const double t2 = th * th;
            const double* kc = s5_kc; asm volatile("" : "+s"(kc));
            double cs = 1.0 - t2 * (0.5 - t2 * (kc[0] - t2 * (kc[1] - t2 * (kc[2] - t2 * (kc[3] - t2 * kc[4])))));
            double sn = th * (1.0 - t2 * (kc[5] - t2 * (kc[6] - t2 * (kc[7] - t2 * (kc[8] - t2 * (kc[9] - t2 * kc[10]))))));
#pragma unroll
            for (int r = 0; r < 3; ++r) { const double c2 = cs * cs - sn * sn, s2 = 2.0 * cs * sn; cs = c2; sn = s2; }
            const double abr = mag * cs, abi = mag * sn, den = lr * lr + li * li;
            const double cr = ((abr - 1.0) * lr + abi * li) / den, ci = (abi * lr - (abr - 1.0) * li) / den;
            double pr = 1.0, pi = 0.0;
#pragma unroll 1
            for (int t = 0; t <= 16; ++t) { abp[(t * 64 + p) * 2] = (float)pr; abp[(t * 64 + p) * 2 + 1] = (float)pi; const double nr = pr * abr - pi * abi, ni = pr * abi + pi * abr; if (t < 16) { pr = nr; pi = ni; } }
            float* tb = WSF(WS_TBL) + (size_t)idx * 8;
            if (part == 0) { tb[0] = (float)abr; tb[1] = (float)abi; tb[2] = (float)cr; tb[3] = (float)ci; tb[4] = (float)pr; tb[5] = (float)pi; tb[6] = 0.f; tb[7] = 0.f; }
            const float crf = (float)cr, cif = (float)ci;
#pragma unroll 4
            for (int c = 0; c < 16; ++c) { const float br = a.in[I_S5BRE][(size_t)idx * 16 + c], bi = a.in[I_S5BIM][(size_t)idx * 16 + c];
                cB[(p * 16 + c) * 2] = crf * br - cif * bi; cB[(p * 16 + c) * 2 + 1] = crf * bi + cif * br; }
        }
        for (int e = tid; e < 1024; e += NTHR) { const size_t si = (size_t)(j * 64 + g) * 1024 + e; Cc[e * 2] = a.in[I_S5CRE][si]; Cc[e * 2 + 1] = a.in[I_S5CIM][si]; }
        __syncthreads();
        if (tid < 256) {
            const int tau = tid >> 4, c1 = tid & 15; float acc[16];
#pragma unroll
            for (int c = 0; c < 16; ++c) acc[c] = 0.f;
#pragma unroll 2
            for (int p = 0; p < 64; ++p) {
                const float ar = abp[(tau * 64 + p) * 2], ai = abp[(tau * 64 + p) * 2 + 1], br = cB[(p * 16 + c1) * 2], bi = cB[(p * 16 + c1) * 2 + 1];
                const float wr = ar * br - ai * bi, wi = ar * bi + ai * br;
#pragma unroll
                for (int c = 0; c < 16; ++c) acc[c] += Cc[(c * 64 + p) * 2] * wr - Cc[(c * 64 + p) * 2 + 1] * wi;
            }
#pragma unroll
            for (int c = 0; c < 16; ++c) Kt[(tau * 16 + c) * 16 + c1] = acc[c];
        }
        __syncthreads();
        bf16_t* BC = WSB(WS_AR + AR_S5C) + (size_t)g * 256 * 384;
        for (int e = part * 64 * 192 + tid; e < (part + 1) * 64 * 192; e += NTHR) {
            const int n = e / 192, k2 = (e % 192) * 2, s = n >> 4, c = n & 15; float v[2];
#pragma unroll
            for (int hh = 0; hh < 2; ++hh) { const int k = k2 + hh;
                if (k < 256) { const int s1 = k >> 4, c1 = k & 15; v[hh] = s >= s1 ? Kt[((s - s1) * 16 + c) * 16 + c1] : 0.f; }
                else { const int p = (k - 256) >> 1, part = (k - 256) & 1; const float cr = Cc[(c * 64 + p) * 2], ci = Cc[(c * 64 + p) * 2 + 1], ar = abp[((s + 1) * 64 + p) * 2], ai = abp[((s + 1) * 64 + p) * 2 + 1];
                    v[hh] = part == 0 ? (cr * ar - ci * ai) : -(cr * ai + ci * ar); } }
            *(unsigned*)(BC + (size_t)n * 384 + k2) = pk2(v[0], v[1]);
        }
        bf16_t* BA = WSB(WS_AR + AR_S5A) + (size_t)g * 256 * 256;
        for (int e = part * 64 * 128 + tid; e < (part + 1) * 64 * 128; e += NTHR) {
            const int n = e >> 7, k2 = (e & 127) * 2; float v[2] = {0.f, 0.f};
            if (n < 128) { const int p = n >> 1, part = n & 1;
#pragma unroll
                for (int hh = 0; hh < 2; ++hh) { const int k = k2 + hh, s1 = k >> 4, c1 = k & 15; const float ar = abp[((15 - s1) * 64 + p) * 2], ai = abp[((15 - s1) * 64 + p) * 2 + 1], br = cB[(p * 16 + c1) * 2], bi = cB[(p * 16 + c1) * 2 + 1];
                    v[hh] = part == 0 ? (ar * br - ai * bi) : (ar * bi + ai * br); } }
            *(unsigned*)(BA + (size_t)n * 256 + k2) = pk2(v[0], v[1]);
        }
    }
    __syncthreads();
}

__device__ __forceinline__ void s5_u_phase(ArgsR a, int li, int j) {
    const int tid = otid(), lane = tid & 63, wave = tid >> 6, gw = obid() * 8 + wave, NGW = gridDim.x * 8;
    const float* X = li == 0 ? a.in[I_XP] : a.out; const float* SSQ = WSF(WS_SSQ); const float* gm = a.in[I_NMIX] + li * 1024; bf16_t* A2 = WSB(WS_AR + AR_A2);
    for (int it = gw; it < 4096; it += NGW) {
        const int qd = it & 3, jj = (it >> 2) & 127, b = it >> 9, t0 = b * LSEQ + jj * 16;
        float rs = 0.f;
        { const int s = lane & 15; const float* sp = SSQ + (size_t)(t0 + s) * 32; float q = 0.f;
#pragma unroll
          for (int e = 0; e < 8; ++e) { const f32x4 v = *(const f32x4*)(sp + e * 4); q += (v[0] + v[1]) + (v[2] + v[3]); }
          rs = rstd_from(q); }
        const int s = (lane >> 1) & 15, hf = lane & 1; const float rss = __shfl(rs, s);
        f32x4 xa[8], xb[8];
#pragma unroll
        for (int i = 0; i < 8; ++i) { const int g = (qd * 8 + i) * 2 + (lane >> 5), ch0 = g * 16 + hf * 8; xa[i] = *(const f32x4*)(X + (size_t)(t0 + s) * D + ch0); xb[i] = *(const f32x4*)(X + (size_t)(t0 + s) * D + ch0 + 4); }
#pragma unroll
        for (int i = 0; i < 8; ++i) {
            const int g = (qd * 8 + i) * 2 + (lane >> 5), ch0 = g * 16 + hf * 8;
            const f32x4 g0 = *(const f32x4*)(gm + ch0), g1 = *(const f32x4*)(gm + ch0 + 4);
            const f32x4 u0 = xa[i] * g0 * rss, u1 = xb[i] * g1 * rss; const u32x2 p0 = pk4(u0), p1 = pk4(u1);
            *(u32x4*)(A2 + (size_t)(g * 1024 + b * 128 + jj) * 384 + s * 16 + hf * 8) = (u32x4){p0.x, p0.y, p1.x, p1.y};
        }
    }
    const float* TBL = WSF(WS_TBL); bf16_t* YB = WSB(WS_AR + AR_YB);
    for (int it = gw; it < 128 * 64; it += NGW) {
        const int g = it & 63, bs = it >> 6, row = MP + bs, p = lane;
        float q = lane < 32 ? SSQ[(size_t)row * 32 + lane] : 0.f; q = wave_sum(q); const float rs = rstd_from(q);
        const int cc = lane & 15; const float* xsr = li == 0 ? a.in[I_XS] + (size_t)bs * D : a.out + (size_t)row * D; const float uc = xsr[g * 16 + cc] * rs * gm[g * 16 + cc];
        const size_t pi = (size_t)((j * 64 + g) * 64 + p);
        float bur = 0.f, bui = 0.f;
#pragma unroll
        for (int c = 0; c < 16; ++c) { const float u = __shfl(uc, c); bur += a.in[I_S5BRE][pi * 16 + c] * u; bui += a.in[I_S5BIM][pi * 16 + c] * u; }
        const float* tb = TBL + pi * 8; const float abr = tb[0], abi = tb[1], cr = tb[2], ci = tb[3];
        const size_t si = (size_t)(j * 128 + bs) * 4096 + g * 64 + p;
        const float h0r = a.in[I_S5RE][si], h0i = a.in[I_S5IM][si];
        const float hr = abr * h0r - abi * h0i + (cr * bur - ci * bui), hi = abr * h0i + abi * h0r + (cr * bui + ci * bur);
        a.out[O_S5RE_S + si] = hr; a.out[O_S5IM_S + si] = hi;
        float yv = 0.f; float tsum[16];
#pragma unroll
        for (int c = 0; c < 16; ++c) { const size_t ci2 = (size_t)((j * 64 + g) * 16 + c) * 64 + p; tsum[c] = a.in[I_S5CRE][ci2] * hr - a.in[I_S5CIM][ci2] * hi; }
#pragma unroll
        for (int o = 1; o < 64; o <<= 1) {
#pragma unroll
            for (int c = 0; c < 16; ++c) tsum[c] += __shfl_xor(tsum[c], o); }
#pragma unroll
        for (int c = 0; c < 16; ++c) if (cc == c) yv = tsum[c];
        if (lane < 16) { const float y = yv + a.in[I_S5D][j * 1024 + g * 16 + cc] * uc; YB[(size_t)row * D + g * 16 + cc] = (bf16_t)f2bf(gelu_tanh(y)); }
    }
}
__device__ __forceinline__ void s5_carry_phase(ArgsR a, int j) {
    const int gt = obid() * NTHR + otid(), NGT = gridDim.x * NTHR, lane = otid() & 63, lb = lane & ~3;
    const float* TBL = WSF(WS_TBL); const float* HL = WSF(WS_AR + AR_HLOC); bf16_t* A2 = WSB(WS_AR + AR_A2);
    for (int id = gt; id < 131072; id += NGT) {
        const int sg = id & 3, p = (id >> 2) & 63, g = (id >> 8) & 63, b = id >> 14; const float* tb = TBL + (size_t)((j * 64 + g) * 64 + p) * 8; const float ar = tb[4], ai = tb[5];
        const size_t row0 = (size_t)g * 1024 + b * 128 + sg * 32;
        float er = 0.f, ei = 0.f;
#pragma unroll 16
        for (int k = 0; k < 32; ++k) { const f32x2 hl = *(const f32x2*)(HL + (row0 + k) * 128 + 2 * p); const float nr = ar * er - ai * ei + hl.x, ni = ar * ei + ai * er + hl.y; er = nr; ei = ni; }
        float pr = ar, pi = ai;
#pragma unroll
        for (int q = 0; q < 5; ++q) { const float nr = pr * pr - pi * pi, ni = 2.f * pr * pi; pr = nr; pi = ni; }
        const float e0r = __shfl(er, lb), e0i = __shfl(ei, lb), e1r = __shfl(er, lb + 1), e1i = __shfl(ei, lb + 1), e2r = __shfl(er, lb + 2), e2i = __shfl(ei, lb + 2);
        const float h1r = e0r, h1i = e0i;
        const float h2r = pr * h1r - pi * h1i + e1r, h2i = pr * h1i + pi * h1r + e1i;
        const float h3r = pr * h2r - pi * h2i + e2r, h3i = pr * h2i + pi * h2r + e2i;
        float hr = sg == 0 ? 0.f : (sg == 1 ? h1r : (sg == 2 ? h2r : h3r)), hi = sg == 0 ? 0.f : (sg == 1 ? h1i : (sg == 2 ? h2i : h3i));
#pragma unroll 1
        for (int k0 = 0; k0 < 32; k0 += 16) { f32x2 hl[16];
#pragma unroll
            for (int k = 0; k < 16; ++k) hl[k] = *(const f32x2*)(HL + (row0 + k0 + k) * 128 + 2 * p);
#pragma unroll
            for (int k = 0; k < 16; ++k) { *(unsigned*)(A2 + (row0 + k0 + k) * 384 + 256 + 2 * p) = pk2(hr, hi);
                const float nr = ar * hr - ai * hi + hl[k].x, ni = ar * hi + ai * hr + hl[k].y; hr = nr; hi = ni; } }
        if (sg == 3) { const size_t so = (size_t)(j * 8 + b) * 4096 + g * 64 + p; a.out[O_S5RE_P + so] = hr; a.out[O_S5IM_P + so] = hi; }
    }
}

__device__ __forceinline__ void unpk8(u32x4 w, float* x) { x[0] = bflo(w.x); x[1] = bfhi(w.x); x[2] = bflo(w.y); x[3] = bfhi(w.y); x[4] = bflo(w.z); x[5] = bfhi(w.z); x[6] = bflo(w.w); x[7] = bfhi(w.w); }
__device__ __forceinline__ void ffn_conv_phase(ArgsR a, int li, bool st = true) {
    const int gt = obid() * NTHR + otid(), NGT = gridDim.x * NTHR;
    const bf16_t* G = WSB(WS_AR + AR_G); bf16_t* UP = WSB(WS_AR + AR_UP);
    const float* cw = a.in[I_FCW] + (size_t)li * 3 * FF; const float* cb = a.in[I_FCB] + (size_t)li * FF;
    for (int it = gt; it < (MP / 4) * (FF / 8); it += NGT) {
        const int rq = it / (FF / 8), f = (it % (FF / 8)) * 8, row0 = rq * 4, l0 = row0 & (LSEQ - 1);
        u32x4 g[6], uw[4];
        const u32x4 z = {0, 0, 0, 0};
        g[0] = l0 ? *(const u32x4*)(G + (size_t)(row0 - 2) * FF + f) : z; g[1] = l0 ? *(const u32x4*)(G + (size_t)(row0 - 1) * FF + f) : z;
#pragma unroll
        for (int r = 0; r < 4; ++r) { g[2 + r] = *(const u32x4*)(G + (size_t)(row0 + r) * FF + f); uw[r] = *(const u32x4*)(UP + (size_t)(row0 + r) * FF + f); }
        float w0[8], w1[8], w2[8], bb[8];
#pragma unroll
        for (int e = 0; e < 8; ++e) { w0[e] = cw[f + e]; w1[e] = cw[FF + f + e]; w2[e] = cw[2 * FF + f + e]; bb[e] = cb[f + e]; }
        float x[6][8];
#pragma unroll
        for (int r = 0; r < 6; ++r) unpk8(g[r], x[r]);
#pragma unroll
        for (int r = 0; r < 4; ++r) {
            float up[8], o[8]; unpk8(uw[r], up);
#pragma unroll
            for (int e = 0; e < 8; ++e) { const float c = bb[e] + x[r][e] * w0[e] + x[r + 1][e] * w1[e] + x[r + 2][e] * w2[e]; o[e] = c * sigmoidf_(c) * up[e]; }
            u32x4 ov; ov.x = pk2(o[0], o[1]); ov.y = pk2(o[2], o[3]); ov.z = pk2(o[4], o[5]); ov.w = pk2(o[6], o[7]);
            if (st) *(u32x4*)(UP + (size_t)(row0 + r) * FF + f) = ov;
        }
        if (st && l0 == LSEQ - 4) { float* o = a.out + O_FC_P + ((size_t)(li * 8 + (row0 >> 11)) * 2) * FF + f;
#pragma unroll
            for (int e = 0; e < 8; ++e) { o[e] = x[4][e]; o[FF + e] = x[5][e]; } }
    }
    if (st)
    for (int it = gt; it < MS * (FF / 8); it += NGT) {
        const int bs = it / (FF / 8), f = (it % (FF / 8)) * 8, row = MP + bs;
        float x0[8], x1[8], x2[8], up[8], r[8];
        unpk8(*(const u32x4*)(G + (size_t)row * FF + f), x2); unpk8(*(const u32x4*)(UP + (size_t)row * FF + f), up);
        const float* st = a.in[I_FC] + ((size_t)(li * 128 + bs) * 2) * FF + f; float* o = a.out + O_FC_S + ((size_t)(li * 128 + bs) * 2) * FF + f;
#pragma unroll
        for (int e = 0; e < 8; ++e) { x0[e] = st[e]; x1[e] = st[FF + e]; }
#pragma unroll
        for (int e = 0; e < 8; ++e) { o[e] = x1[e]; o[FF + e] = x2[e]; const float c = cb[f + e] + x0[e] * cw[f + e] + x1[e] * cw[FF + f + e] + x2[e] * cw[2 * FF + f + e]; r[e] = c * sigmoidf_(c) * up[e]; }
        u32x4 ov; ov.x = pk2(r[0], r[1]); ov.y = pk2(r[2], r[3]); ov.z = pk2(r[4], r[5]); ov.w = pk2(r[6], r[7]);
        *(u32x4*)(UP + (size_t)row * FF + f) = ov;
    }
}

__device__ __forceinline__ void rw1_phase(ArgsR a, int li) {
    const int tid = otid(), lane = tid & 63, wave = tid >> 6, gw = obid() * 8 + wave, NGW = gridDim.x * 8;
    const float* X = a.out; const float* SSQ = WSF(WS_SSQ); const float* gm = a.in[I_NMIX] + li * 1024; bf16_t* HX = WSB(WS_AR + AR_HX);
    for (int row = gw; row < MA; row += NGW) {
        const bool prm = row < MP; const int l = row & (LSEQ - 1); const bool hasprev = prm && l > 0;
        float q = 0.f;
        if (lane < 32) q = SSQ[(size_t)row * 32 + lane]; else if (hasprev) q = SSQ[(size_t)(row - 1) * 32 + lane - 32];
        f32x4 xv[4], pv[4], g4[4];
        const float* prow = hasprev ? X + (size_t)(row - 1) * D : (prm ? X + (size_t)row * D : a.in[I_SHIFT] + (size_t)(row - MP) * D);
#pragma unroll
        for (int qq = 0; qq < 4; ++qq) { const int c = lane * 4 + 256 * qq; xv[qq] = *(const f32x4*)(X + (size_t)row * D + c); pv[qq] = *(const f32x4*)(prow + c); g4[qq] = *(const f32x4*)(gm + c); }
#pragma unroll
        for (int o = 1; o < 32; o <<= 1) q += __shfl_xor(q, o);
        const float rs = rstd_from(__shfl(q, 0)), rsp = rstd_from(__shfl(q, 32));
#pragma unroll
        for (int qq = 0; qq < 4; ++qq) {
            const int c = lane * 4 + 256 * qq;
            const f32x4 h = xv[qq] * g4[qq] * rs; f32x4 p = pv[qq];
            if (hasprev) p = p * g4[qq] * rsp; else if (prm) p = (f32x4){0.f, 0.f, 0.f, 0.f};
            *(u32x2*)(HX + (size_t)row * 2048 + c) = pk4(h); *(u32x2*)(HX + (size_t)row * 2048 + 1024 + c) = pk4(p - h);
            if (!prm) *(f32x4*)(a.out + O_SH_S + (size_t)(row - MP) * D + c) = h;
            else if (l == LSEQ - 1) *(f32x4*)(a.out + O_SH_P + (size_t)(row >> 11) * D + c) = h;
        }
    }
}

struct RwPrep { f32x4 nk, w, ka, kp, r; float bd; };
__device__ __forceinline__ RwPrep rw_prep(u32x2 rr, u32x2 rk, u32x2 rd, u32x2 ra, f32x4 kkc, f32x4 kac, f32x4 rkc) {
    RwPrep o; const f32x4 r = unpk4(rr), k = unpk4(rk), d = unpk4(rd), aa = unpk4(ra);
    const f32x4 kk = k * kkc; float ss = (kk[0] * kk[0] + kk[1] * kk[1]) + (kk[2] * kk[2] + kk[3] * kk[3]); ss = row16_sum(ss);
    const float inv = 1.f / fmaxf(sqrtf(ss), 1e-12f); const f32x4 kkn = kk * inv;
    o.nk = -kkn; o.ka = kkn * aa; o.kp = k * (1.f + (aa - 1.f) * kac); o.w = 1.f - d; o.r = r;
    const f32x4 t = r * o.kp * rkc; float bd = (t[0] + t[1]) + (t[2] + t[3]); o.bd = row16_sum(bd);
    return o;
}
__device__ __forceinline__ void rw4_phase(ArgsR a, LAS unsigned char* lds) {
    const int tid = otid(), il = tid >> 4, jl = tid & 15, tt = tid >> 4, c4 = (tid & 15) * 4;
    const bf16_t* Rg = WSB(WS_AR + AR_RKV); const bf16_t* Kg = Rg + RKV_PLANE / 2; const bf16_t* Vg = Rg + RKV_PLANE;
    const bf16_t* DEC = WSB(WS_AR + AR_DEC); const bf16_t* AA = WSB(WS_AR + AR_AA);
    bf16_t* ORAW = WSB(WS_XB); float* BD = WSF(WS_CAR);
    LAS float* L = (LAS float*)lds; constexpr int ARR = 2048;
    LAS float* OL = L + 12 * ARR; LAS float* BON = OL + 1024;
    for (int rep = 0; rep < (PROBE_RW4 ? 2 : 1); ++rep)
    for (int item = obid(); item < 256; item += gridDim.x) {
        const bool wr_ = rep == (PROBE_RW4 ? 1 : 0);
        const int half = item & 1, h = (item >> 1) & 15, b = item >> 5, irow = half * 32 + il;
        const f32x4 kkc = *(const f32x4*)(a.in[I_RWKK] + h * 64 + c4), kac = *(const f32x4*)(a.in[I_RWKA] + h * 64 + c4), rkc = *(const f32x4*)(a.in[I_RWRK] + h * 64 + c4);
        f32x4 S = {0.f, 0.f, 0.f, 0.f};
        size_t off = (size_t)(b * LSEQ + tt) * D + h * 64 + c4;
        u32x2 rr = *(const u32x2*)(Rg + off), rk = *(const u32x2*)(Kg + off), rv = *(const u32x2*)(Vg + off), rd = *(const u32x2*)(DEC + off), ra = *(const u32x2*)(AA + off);
        __syncthreads();
#pragma unroll 1
        for (int c = 0; c < LSEQ / 32; ++c) {
            const int bi = c & 1; LAS float* B = L + bi * 6 * ARR;
            { const RwPrep pp = rw_prep(rr, rk, rd, ra, kkc, kac, rkc); const int o = tt * 64 + c4;
              *(LAS f32x4*)(B + 0 * ARR + o) = pp.nk; *(LAS f32x4*)(B + 1 * ARR + o) = pp.w; *(LAS f32x4*)(B + 2 * ARR + o) = pp.ka; *(LAS f32x4*)(B + 3 * ARR + o) = pp.kp;
              *(LAS f32x4*)(B + 4 * ARR + o) = pp.r; *(LAS f32x4*)(B + 5 * ARR + o) = unpk4(rv); if (jl == 0) BON[bi * 32 + tt] = pp.bd; }
            __syncthreads();
            const int row0 = b * LSEQ + c * 32;
            if (c + 1 < LSEQ / 32) { off += (size_t)32 * D;
                rr = *(const u32x2*)(Rg + off); rk = *(const u32x2*)(Kg + off); rv = *(const u32x2*)(Vg + off); rd = *(const u32x2*)(DEC + off); ra = *(const u32x2*)(AA + off); }
            {
                const LAS float* Bj = B + jl * 4; const LAS float* Bv = B + 5 * ARR + irow;
                f32x4 nk = *(const LAS f32x4*)(Bj), ww = *(const LAS f32x4*)(Bj + ARR), ka = *(const LAS f32x4*)(Bj + 2 * ARR), kq = *(const LAS f32x4*)(Bj + 3 * ARR), rq = *(const LAS f32x4*)(Bj + 4 * ARR);
                float vv = Bv[0];
#pragma unroll 1
                for (int t4 = 0; t4 < 32; t4 += 4) {
                    float qs[4];
#pragma unroll
                    for (int u = 0; u < 4; ++u) {
                        const int tn = (t4 + u + 1) & 31;
                        const f32x4 nk2 = *(const LAS f32x4*)(Bj + tn * 64), ww2 = *(const LAS f32x4*)(Bj + ARR + tn * 64), ka2 = *(const LAS f32x4*)(Bj + 2 * ARR + tn * 64),
                                    kq2 = *(const LAS f32x4*)(Bj + 3 * ARR + tn * 64), rq2 = *(const LAS f32x4*)(Bj + 4 * ARR + tn * 64);
                        const float vv2 = Bv[tn * 64];
                        float p0 = S[0] * nk[0]; p0 = __builtin_fmaf(S[1], nk[1], p0); p0 = __builtin_fmaf(S[2], nk[2], p0); p0 = __builtin_fmaf(S[3], nk[3], p0);
                        p0 = row16_sum(p0);
                        S = S * ww + ka * p0 + kq * vv;
                        float q0 = S[0] * rq[0]; q0 = __builtin_fmaf(S[1], rq[1], q0); q0 = __builtin_fmaf(S[2], rq[2], q0); q0 = __builtin_fmaf(S[3], rq[3], q0);
                        qs[u] = row16_sum(q0);
                        nk = nk2; ww = ww2; ka = ka2; kq = kq2; rq = rq2; vv = vv2;
                    }
                    if (jl == 0) { OL[(t4 + 0) * 32 + il] = qs[0]; OL[(t4 + 1) * 32 + il] = qs[1]; OL[(t4 + 2) * 32 + il] = qs[2]; OL[(t4 + 3) * 32 + il] = qs[3]; }
                }
            }
            __syncthreads();
            if (wr_) { const f32x2 ov = *(const LAS f32x2*)(OL + tt * 32 + jl * 2);
                *(unsigned*)(ORAW + (size_t)(row0 + tt) * D + h * 64 + half * 32 + jl * 2) = pk2(ov.x, ov.y);
                if (half == 0 && tid < 32) BD[(size_t)(row0 + tid) * 16 + h] = BON[bi * 32 + tid]; }
        }
        if (wr_) *(f32x4*)(a.out + O_WKV_P + ((size_t)(b * 16 + h) * 64 + irow) * 64 + jl * 4) = S;
        __syncthreads();
    }
}
__device__ __forceinline__ void rw4b_phase(ArgsR a, LAS unsigned char* lds) {
    const int tid = otid(), rp = tid >> 4, jl = tid & 15, i0 = 2 * rp, i1 = i0 + 1;
    bf16_t* Rg = WSB(WS_AR + AR_RKV); const bf16_t* Kg = Rg + RKV_PLANE / 2; const bf16_t* Vg = Rg + RKV_PLANE;
    const bf16_t* DEC = WSB(WS_AR + AR_DEC); const bf16_t* AA = WSB(WS_AR + AR_AA); const bf16_t* GG = WSB(WS_AR + AR_GG);
    const bf16_t* ORAW = WSB(WS_XB); const float* BD = WSF(WS_CAR);
    LAS float* OL = (LAS float*)lds;
    {
        const int gt = obid() * NTHR + tid, NGT = gridDim.x * NTHR, c4 = jl * 4;
        for (int it = gt >> 4; it < MP * 16; it += 4 * (NGT >> 4)) {
            u32x2 ow[4], vw[4], gw[4]; float bd[4]; int itx[4];
#pragma unroll
            for (int u = 0; u < 4; ++u) { const int ii = it + u * (NGT >> 4); itx[u] = ii < MP * 16 ? ii : it; const size_t oo = (size_t)(itx[u] >> 4) * D + (itx[u] & 15) * 64 + c4;
                ow[u] = *(const u32x2*)(ORAW + oo); vw[u] = *(const u32x2*)(Vg + oo); gw[u] = *(const u32x2*)(GG + oo); bd[u] = BD[itx[u]]; }
#pragma unroll
            for (int u = 0; u < 4; ++u) { const int h = itx[u] & 15; const size_t oo = (size_t)(itx[u] >> 4) * D + h * 64 + c4;
                const f32x4 ov = unpk4(ow[u]), v4 = unpk4(vw[u]), g4 = unpk4(gw[u]);
                const f32x4 lnw = *(const f32x4*)(a.in[I_RWLNW] + h * 64 + c4), lnb = *(const f32x4*)(a.in[I_RWLNB] + h * 64 + c4);
                float sm = (ov[0] + ov[1]) + (ov[2] + ov[3]); sm = row16_sum(sm); const float mean = sm * (1.f / 64.f); const f32x4 dv = ov - mean;
                float vr = (dv[0] * dv[0] + dv[1] * dv[1]) + (dv[2] * dv[2] + dv[3] * dv[3]); vr = row16_sum(vr); const float rstd = 1.f / sqrtf(vr * (1.f / 64.f) + 64e-5f);
                const f32x4 res = (dv * rstd * lnw + lnb + v4 * bd[u]) * g4;
                if (u == 0 || it + u * (NGT >> 4) < MP * 16) *(u32x2*)(Rg + oo) = pk4(res); }
        }
    }
    __syncthreads();
    for (int item = obid(); item < 128 * 16; item += gridDim.x) {
        const int bs = item >> 4, h = item & 15, row = MP + bs; const size_t offj = (size_t)row * D + h * 64 + jl * 4;
        const f32x4 kkc = *(const f32x4*)(a.in[I_RWKK] + h * 64 + jl * 4), kac = *(const f32x4*)(a.in[I_RWKA] + h * 64 + jl * 4), rkc = *(const f32x4*)(a.in[I_RWRK] + h * 64 + jl * 4);
        const RwPrep pp = rw_prep(*(const u32x2*)(Rg + offj), *(const u32x2*)(Kg + offj), *(const u32x2*)(DEC + offj), *(const u32x2*)(AA + offj), kkc, kac, rkc);
        const float v0 = bf1(Vg[(size_t)row * D + h * 64 + i0]), v1 = bf1(Vg[(size_t)row * D + h * 64 + i1]);
        const size_t oo_ = (size_t)row * D + h * 64 + (tid & 15) * 4; const u32x2 vpre = *(const u32x2*)(Vg + oo_), gpre = *(const u32x2*)(GG + oo_);
        const size_t sidx = ((size_t)item * 64 + i0) * 64 + jl * 4;
        f32x4 S0 = *(const f32x4*)(a.in[I_WKV] + sidx), S1 = *(const f32x4*)(a.in[I_WKV] + sidx + 64);
        float p0 = (S0[0] * pp.nk[0] + S0[1] * pp.nk[1]) + (S0[2] * pp.nk[2] + S0[3] * pp.nk[3]), p1 = (S1[0] * pp.nk[0] + S1[1] * pp.nk[1]) + (S1[2] * pp.nk[2] + S1[3] * pp.nk[3]);
        p0 = row16_sum(p0); p1 = row16_sum(p1);
        S0 = S0 * pp.w + pp.ka * p0 + pp.kp * v0; S1 = S1 * pp.w + pp.ka * p1 + pp.kp * v1;
        *(f32x4*)(a.out + O_WKV_S + sidx) = S0; *(f32x4*)(a.out + O_WKV_S + sidx + 64) = S1;
        float q0 = (S0[0] * pp.r[0] + S0[1] * pp.r[1]) + (S0[2] * pp.r[2] + S0[3] * pp.r[3]), q1 = (S1[0] * pp.r[0] + S1[1] * pp.r[1]) + (S1[2] * pp.r[2] + S1[3] * pp.r[3]);
        q0 = row16_sum(q0); q1 = row16_sum(q1);
        if (jl == 0) { OL[i0] = q0; OL[i1] = q1; }
        __syncthreads();
        if (tid < 16) { const int cc = tid * 4; const size_t oo = (size_t)row * D + h * 64 + cc;
            const f32x4 ov = *(const LAS f32x4*)(OL + cc), v4 = unpk4(vpre), g4 = unpk4(gpre);
            const f32x4 lnw = *(const f32x4*)(a.in[I_RWLNW] + h * 64 + cc), lnb = *(const f32x4*)(a.in[I_RWLNB] + h * 64 + cc);
            float sm = (ov[0] + ov[1]) + (ov[2] + ov[3]); sm = row16_sum(sm); const float mean = sm * (1.f / 64.f); const f32x4 dv = ov - mean;
            float vr = (dv[0] * dv[0] + dv[1] * dv[1]) + (dv[2] * dv[2] + dv[3] * dv[3]); vr = row16_sum(vr); const float rstd = 1.f / sqrtf(vr * (1.f / 64.f) + 64e-5f);
            const f32x4 res = (dv * rstd * lnw + lnb + v4 * pp.bd) * g4; *(u32x2*)(Rg + oo) = pk4(res); }
        __syncthreads();
    }
}

__device__ __forceinline__ void lru_conv_phase(ArgsR a) {
    const int gt = obid() * NTHR + otid(), NGT = gridDim.x * NTHR;
    const bf16_t* UPRE = WSB(WS_AR + AR_UPRE); bf16_t* U = WSB(WS_AR + AR_U); const float* cw = a.in[I_LCW]; const float* cb = a.in[I_LCB];
    for (int it = gt; it < (MP / 4) * 128; it += NGT) {
        const int row0 = (it >> 7) * 4, c = (it & 127) * 8, l0 = row0 & (LSEQ - 1);
        u32x4 g[7]; const u32x4 z = {0, 0, 0, 0};
#pragma unroll
        for (int r = 0; r < 3; ++r) g[r] = l0 ? *(const u32x4*)(UPRE + (size_t)(row0 - 3 + r) * D + c) : z;
#pragma unroll
        for (int r = 0; r < 4; ++r) g[3 + r] = *(const u32x4*)(UPRE + (size_t)(row0 + r) * D + c);
        float w[4][8], bb[8], x[7][8];
#pragma unroll
        for (int e = 0; e < 8; ++e) { bb[e] = cb[c + e];
#pragma unroll
            for (int k = 0; k < 4; ++k) w[k][e] = cw[k * D + c + e]; }
#pragma unroll
        for (int r = 0; r < 7; ++r) unpk8(g[r], x[r]);
#pragma unroll
        for (int r = 0; r < 4; ++r) { float o[8];
#pragma unroll
            for (int e = 0; e < 8; ++e) o[e] = bb[e] + x[r][e] * w[0][e] + x[r + 1][e] * w[1][e] + x[r + 2][e] * w[2][e] + x[r + 3][e] * w[3][e];
            u32x4 ov; ov.x = pk2(o[0], o[1]); ov.y = pk2(o[2], o[3]); ov.z = pk2(o[4], o[5]); ov.w = pk2(o[6], o[7]);
            *(u32x4*)(U + (size_t)(row0 + r) * D + c) = ov; }
        if (l0 == LSEQ - 4) { float* o = a.out + O_LC_P + ((size_t)(row0 >> 11) * 3) * D + c;
#pragma unroll
            for (int e = 0; e < 8; ++e) { o[e] = x[4][e]; o[D + e] = x[5][e]; o[2 * D + e] = x[6][e]; } }
    }
    for (int it = gt; it < MS * 256; it += NGT) {
        const int bs = it >> 8, c = (it & 255) * 4, row = MP + bs; f32x4 x[4];
        x[3] = unpk4(*(const u32x2*)(UPRE + (size_t)row * D + c));
        const float* st = a.in[I_LC] + (size_t)bs * 3 * D + c; float* o = a.out + O_LC_S + (size_t)bs * 3 * D + c;
#pragma unroll
        for (int k = 0; k < 3; ++k) x[k] = *(const f32x4*)(st + k * D);
        *(f32x4*)o = x[1]; *(f32x4*)(o + D) = x[2]; *(f32x4*)(o + 2 * D) = x[3];
        f32x4 r = *(const f32x4*)(cb + c);
#pragma unroll
        for (int k = 0; k < 4; ++k) r += x[k] * *(const f32x4*)(cw + k * D + c);
        *(u32x2*)(U + (size_t)row * D + c) = pk4(r);
    }
}
__device__ __forceinline__ void lru_scan1_phase(ArgsR a, bool st = true) {
    const int gt = obid() * NTHR + otid(), NGT = gridDim.x * NTHR; constexpr int NIT = 8 * 32 * 1024;
    const float* AF = WSF(WS_AR + AR_AF); const bf16_t* BX = WSB(WS_AR + AR_BX); bf16_t* GATE = WSB(WS_AR + AR_GATE); float* CAR = WSF(WS_CAR);
    for (int id = gt; id < NIT; id += 2 * NGT) {
        const int id1 = id + NGT < NIT ? id + NGT : id; size_t o[2]; float ap[2] = {1.f, 1.f}, h[2] = {0.f, 0.f};
        o[0] = (size_t)((id >> 15) * LSEQ + ((id >> 10) & 31) * 64) * D + (id & 1023); o[1] = (size_t)((id1 >> 15) * LSEQ + ((id1 >> 10) & 31) * 64) * D + (id1 & 1023);
#pragma unroll 1
        for (int t0 = 0; t0 < 64; t0 += 8) { float av[2][8], bv[2][8];
#pragma unroll
            for (int u = 0; u < 2; ++u)
#pragma unroll
                for (int t = 0; t < 8; ++t) { av[u][t] = AF[o[u] + (size_t)t * D]; bv[u][t] = bf1(BX[o[u] + (size_t)t * D]); }
#pragma unroll
            for (int u = 0; u < 2; ++u) {
#pragma unroll
                for (int t = 0; t < 8; ++t) { h[u] = av[u][t] * h[u] + bv[u][t]; ap[u] *= av[u][t]; }
                o[u] += (size_t)8 * D; } }
        *(f32x2*)(CAR + (size_t)id * 2) = (f32x2){ap[0], h[0]}; if (id1 != id) *(f32x2*)(CAR + (size_t)id1 * 2) = (f32x2){ap[1], h[1]};
    }
    if (st)
    for (int id = gt; id < MS * 1024; id += NGT) {
        const int ch = id & 1023, bs = id >> 10; const size_t o = (size_t)(MP + bs) * D + ch;
        const float h = AF[o] * a.in[I_LH][id] + bf1(BX[o]); a.out[O_LH_S + id] = h; GATE[o] = (bf16_t)f2bf(h * bf1(GATE[o]));
    }
}
__device__ __forceinline__ void lru_scan2_phase(ArgsR a, bool st = true) {
    const int gt = obid() * NTHR + otid(), NGT = gridDim.x * NTHR; constexpr int NIT = 8 * 32 * 1024;
    const float* AF = WSF(WS_AR + AR_AF); const bf16_t* BX = WSB(WS_AR + AR_BX); bf16_t* GATE = WSB(WS_AR + AR_GATE); const float* CAR = WSF(WS_CAR);
    (void)st;
    for (int id = gt; id < NIT; id += 2 * NGT) {
        const int id1 = id + NGT < NIT ? id + NGT : id; int idv[2] = {id, id1}; float h[2]; size_t o[2];
#pragma unroll
        for (int u = 0; u < 2; ++u) {
            const int ch = idv[u] & 1023, ck = (idv[u] >> 10) & 31, b = idv[u] >> 15; f32x2 cv[31];
#pragma unroll
            for (int c2 = 0; c2 < 31; ++c2) cv[c2] = *(const f32x2*)(CAR + ((size_t)(b * 32 + c2) * 1024 + ch) * 2);
            float hh = 0.f;
#pragma unroll
            for (int c2 = 0; c2 < 31; ++c2) hh = c2 < ck ? cv[c2].x * hh + cv[c2].y : hh;
            h[u] = hh; o[u] = (size_t)(b * LSEQ + ck * 64) * D + ch;
        }
#pragma unroll 1
        for (int t0 = 0; t0 < 64; t0 += 8) { float av[2][8], bv[2][8], gv[2][8];
#pragma unroll
            for (int u = 0; u < 2; ++u)
#pragma unroll
                for (int t = 0; t < 8; ++t) { av[u][t] = AF[o[u] + (size_t)t * D]; bv[u][t] = bf1(BX[o[u] + (size_t)t * D]); gv[u][t] = bf1(GATE[o[u] + (size_t)t * D]); }
#pragma unroll
            for (int u = 0; u < 2; ++u) { if (u == 1 && id1 == id) break;
#pragma unroll
                for (int t = 0; t < 8; ++t) { h[u] = av[u][t] * h[u] + bv[u][t]; GATE[o[u] + (size_t)t * D] = (bf16_t)f2bf(h[u] * gv[u][t]); }
                o[u] += (size_t)8 * D; } }
#pragma unroll
        for (int u = 0; u < 2; ++u) if (((idv[u] >> 10) & 31) == 31 && (u == 0 || id1 != id)) a.out[O_LH_P + (idv[u] >> 15) * 1024 + (idv[u] & 1023)] = h[u];
    }
}
__device__ __forceinline__ void lru_scan_fused(ArgsR a, LAS unsigned char* lds) {
    const int tid = otid(), ck = tid >> 4, cl = tid & 15;
    const float* AF = WSF(WS_AR + AR_AF); const bf16_t* BX = WSB(WS_AR + AR_BX); bf16_t* GATE = WSB(WS_AR + AR_GATE);
    LAS f32x4* car = (LAS f32x4*)lds;
    for (int item = obid(); item < 256; item += gridDim.x) {
        const int b = item >> 5, ch0 = (item & 31) * 32 + cl * 2; const size_t o0 = (size_t)(b * LSEQ + ck * 64) * D + ch0;
        float ap0 = 1.f, ap1 = 1.f, h0 = 0.f, h1 = 0.f; size_t o = o0;
#pragma unroll 1
        for (int t0 = 0; t0 < 64; t0 += 8) { f32x2 av[8]; unsigned bv[8];
#pragma unroll
            for (int t = 0; t < 8; ++t) { av[t] = *(const f32x2*)(AF + o + (size_t)t * D); bv[t] = *(const unsigned*)(BX + o + (size_t)t * D); }
#pragma unroll
            for (int t = 0; t < 8; ++t) { h0 = av[t].x * h0 + bflo(bv[t]); h1 = av[t].y * h1 + bfhi(bv[t]); ap0 *= av[t].x; ap1 *= av[t].y; }
            o += (size_t)8 * D; }
        __syncthreads();
        car[ck * 16 + cl] = (f32x4){ap0, h0, ap1, h1};
        __syncthreads();
        h0 = 0.f; h1 = 0.f;
        for (int c2 = 0; c2 < ck; ++c2) { const f32x4 cv = car[c2 * 16 + cl]; h0 = cv[0] * h0 + cv[1]; h1 = cv[2] * h1 + cv[3]; }
        o = o0;
#pragma unroll 1
        for (int t0 = 0; t0 < 64; t0 += 8) { f32x2 av[8]; unsigned bv[8], gv[8];
#pragma unroll
            for (int t = 0; t < 8; ++t) { av[t] = *(const f32x2*)(AF + o + (size_t)t * D); bv[t] = *(const unsigned*)(BX + o + (size_t)t * D); gv[t] = *(const unsigned*)(GATE + o + (size_t)t * D); }
#pragma unroll
            for (int t = 0; t < 8; ++t) { h0 = av[t].x * h0 + bflo(bv[t]); h1 = av[t].y * h1 + bfhi(bv[t]); *(unsigned*)(GATE + o + (size_t)t * D) = pk2(h0 * bflo(gv[t]), h1 * bfhi(gv[t])); }
            o += (size_t)8 * D; }
        if (ck == 31) { a.out[O_LH_P + b * 1024 + ch0] = h0; a.out[O_LH_P + b * 1024 + ch0 + 1] = h1; }
    }
    __syncthreads();
    const int gt = obid() * NTHR + tid, NGT = gridDim.x * NTHR;
    for (int id = gt; id < MS * 1024; id += NGT) {
        const int ch = id & 1023, bs = id >> 10; const size_t o = (size_t)(MP + bs) * D + ch;
        const float h = AF[o] * a.in[I_LH][id] + bf1(BX[o]); a.out[O_LH_S + id] = h; GATE[o] = (bf16_t)f2bf(h * bf1(GATE[o]));
    }
}
__device__ __forceinline__ void final_phase(ArgsR a, bool st = true) {
    const int tid = otid(), lane = tid & 63, wave = tid >> 6, gw = obid() * 8 + wave, NGW = gridDim.x * 8;
    const float* SSQ = WSF(WS_SSQ); const float* gm = a.in[I_NFIN];
    (void)st;
    for (int row0 = gw; row0 < MA; row0 += 4 * NGW) {
        f32x4 xv[4][4]; float q[4]; int rws[4];
#pragma unroll
        for (int u = 0; u < 4; ++u) { const int row = row0 + u * NGW < MA ? row0 + u * NGW : row0; rws[u] = row;
            q[u] = lane < 32 ? SSQ[(size_t)row * 32 + lane] : 0.f;
#pragma unroll
            for (int qq = 0; qq < 4; ++qq) xv[u][qq] = *(const f32x4*)(a.out + (size_t)row * D + lane * 4 + 256 * qq); }
#pragma unroll
        for (int o = 1; o < 64; o <<= 1) {
#pragma unroll
            for (int u = 0; u < 4; ++u) q[u] += __shfl_xor(q[u], o); }
#pragma unroll
        for (int u = 0; u < 4; ++u) if (u == 0 || row0 + u * NGW < MA) { const float rs = rstd_from(q[u]);
#pragma unroll
            for (int qq = 0; qq < 4; ++qq) { const int c = lane * 4 + 256 * qq; *(f32x4*)(a.out + (size_t)rws[u] * D + c) = xv[u][qq] * *(const f32x4*)(gm + c) * rs; } }
    }
}


#define XB_TMO      128
#define XB_XCNT(j)  (256  + 64 * (j))
#define XB_XSUB(j)  (1280 + 64 * (j))
#define XB_XGEN(j)  (2304 + 64 * (j))
#define XB_TOP      3328
#define XB_TOPGEN   3392
#define XCD_BAR_WORDS 3456
#define XB_SPIN_CAP (1u << 18)
__device__ __forceinline__ unsigned xb_ld(unsigned* p)              { return __hip_atomic_load(p, __ATOMIC_RELAXED, __HIP_MEMORY_SCOPE_AGENT); }
__device__ __forceinline__ unsigned xb_add(unsigned* p, unsigned v) { return __hip_atomic_fetch_add(p, v, __ATOMIC_RELAXED, __HIP_MEMORY_SCOPE_AGENT); }
__device__ __forceinline__ unsigned xb_xcc_id() { return (unsigned)__builtin_amdgcn_s_getreg((3 << 11) | 20) & 0xFu; }
#define XB_SPIN(cond, bar) do { unsigned _sp = 0; while (cond) { \
    if ((++_sp & 255u) == 0u) { if (xb_ld(&(bar)[XB_TMO])) break; if (_sp > XB_SPIN_CAP) { atomicAdd(&(bar)[XB_TMO], 1u); break; } } } } while (0)
struct XcdBarrier { unsigned* bar; unsigned x; volatile LAS unsigned* st; };
__device__ __forceinline__ XcdBarrier xcd_barrier_post(unsigned* bar, volatile LAS unsigned* st) {
    XcdBarrier b; b.bar = bar; b.x = xb_xcc_id(); b.st = st;
    if (threadIdx.x == 0) (void)xb_add(&bar[XB_XCNT(b.x)], 1u);
    return b;
}
__device__ __forceinline__ void xcd_barrier_complete(unsigned* bar, unsigned x, unsigned& nloc, unsigned& nx) {
    const unsigned G = gridDim.x * gridDim.y * gridDim.z;
    unsigned sum, cnt, mine, sp = 0u;
    for (;;) {
        sum = 0u; cnt = 0u; mine = 0u;
#pragma unroll
        for (unsigned j = 0; j < 16; ++j) { const unsigned c = xb_ld(&bar[XB_XCNT(j)]); sum += c; cnt += (c > 0u) ? 1u : 0u; mine = (j == x) ? c : mine; }
        if (sum == G) break;
        __builtin_amdgcn_s_sleep(1);
        if ((++sp & 255u) == 0u) { if (xb_ld(&bar[XB_TMO])) break; if (sp > XB_SPIN_CAP) { atomicAdd(&bar[XB_TMO], 1u); break; } }
    }
    nloc = mine > 0u ? mine : 1u; nx = cnt > 0u ? cnt : 1u;
}
__device__ __forceinline__ void xcd_barrier(const XcdBarrier& b) {
    asm volatile("s_waitcnt vmcnt(0)" ::: "memory");
    __syncthreads();
    if (threadIdx.x == 0) {
        unsigned* bar = b.bar;
        __builtin_amdgcn_s_waitcnt(0);
        unsigned nloc = b.st[0], nx = b.st[1];
        if (nloc == 0u) { xcd_barrier_complete(bar, b.x, nloc, nx); b.st[0] = nloc; b.st[1] = nx; }
        const unsigned old = xb_add(&bar[XB_XSUB(b.x)], 1u);
        const unsigned gen = old / nloc;
        if (old + 1u == (gen + 1u) * nloc) {
            __builtin_amdgcn_fence(__ATOMIC_RELEASE, "agent");
            asm volatile("s_waitcnt vmcnt(0)" ::: "memory");
            const unsigned og = xb_add(&bar[XB_TOP], 1u);
            const unsigned tg = og / nx;
            if (og + 1u == (tg + 1u) * nx) xb_add(&bar[XB_TOPGEN], 1u);
            else XB_SPIN(xb_ld(&bar[XB_TOPGEN]) == tg, bar);
            __builtin_amdgcn_fence(__ATOMIC_ACQUIRE, "agent");
            xb_add(&bar[XB_XGEN(b.x)], 1u);
            asm volatile("s_waitcnt vmcnt(0)" ::: "memory");
        } else {
            XB_SPIN(xb_ld(&bar[XB_XGEN(b.x)]) == gen, bar);
            __builtin_amdgcn_fence(__ATOMIC_ACQUIRE, "agent");
            asm volatile("s_waitcnt vmcnt(0)" ::: "memory");
        }
    }
    __syncthreads();
}


__device__ __forceinline__ void ffn_fix(ArgsR a, int li) {
    const int tid = otid(); pg8::StaticOrder S; S.init(64, 4, (int)gridDim.x, obid()); pg8::Unit u;
    bf16_t* ACT = WSB(WS_AR + AR_UP); const float* HALO = WSF(WS_AR + AR_G); const float* GFIX = HALO + 64 * 2 * FF; const float* UPFIX = GFIX + 64 * 2 * FF;
    const float* cw = a.in[I_FCW] + (size_t)li * 3 * FF; const float* cb = a.in[I_FCB] + (size_t)li * FF;
    for (int i = 0; S.next(i, u); ++i) {
        const int pm = u.pm; if ((pm & 7) == 0) continue;
        for (int cg = tid; cg < FF / 4; cg += NTHR) {
            const int col = cg * 4;
            const f32x4 gm2 = *(const f32x4*)(HALO + (size_t)((pm - 1) * 2) * FF + col), gm1 = *(const f32x4*)(HALO + (size_t)((pm - 1) * 2 + 1) * FF + col);
            const f32x4 g0 = *(const f32x4*)(GFIX + (size_t)(pm * 2) * FF + col), g1 = *(const f32x4*)(GFIX + (size_t)(pm * 2 + 1) * FF + col);
            const f32x4 u0 = *(const f32x4*)(UPFIX + (size_t)(pm * 2) * FF + col), u1 = *(const f32x4*)(UPFIX + (size_t)(pm * 2 + 1) * FF + col);
            const f32x4 bb = *(const f32x4*)(cb + col), w0 = *(const f32x4*)(cw + col), w1 = *(const f32x4*)(cw + FF + col), w2 = *(const f32x4*)(cw + 2 * FF + col);
            const f32x4 c0 = bb + gm2 * w0 + gm1 * w1 + g0 * w2, c1 = bb + gm1 * w0 + g0 * w1 + g1 * w2; f32x4 o0, o1;
#pragma unroll
            for (int e = 0; e < 4; ++e) { o0[e] = c0[e] * sigmoidf_(c0[e]) * u0[e]; o1[e] = c1[e] * sigmoidf_(c1[e]) * u1[e]; }
            *(u32x2*)(ACT + (size_t)(pm * 256) * FF + col) = pk4(o0); *(u32x2*)(ACT + (size_t)(pm * 256 + 1) * FF + col) = pk4(o1);
        }
    }
    asm volatile("s_waitcnt vmcnt(0)" ::: "memory");
    __syncthreads();
}

#define A2 WSB(WS_AR + AR_A2)
#define YB WSB(WS_AR + AR_YB)
#define HX WSB(WS_AR + AR_HX)
#define RKV WSB(WS_AR + AR_RKV)
#define LORA WSB(WS_AR + AR_LORA)
#define GATE WSB(WS_AR + AR_GATE)
#define UPRE WSB(WS_AR + AR_UPRE)
#define U_ WSB(WS_AR + AR_U)
#define G_ WSB(WS_AR + AR_G)
#define UP_ WSB(WS_AR + AR_UP)
constexpr int LDS_BYTES = 147456;
constexpr int NPHASES = 31;
constexpr int BIG = 1 << 30;

struct EpiNull {
    static constexpr bool IDEMP = false;
    __device__ __forceinline__ void operator()(const f32x4 (&acc)[2][2][4][2], const pg8::Unit&, int, int, int, int) const {
#pragma unroll
        for (int a = 0; a < 2; ++a)
#pragma unroll
            for (int b = 0; b < 2; ++b)
#pragma unroll
                for (int m = 0; m < 4; ++m)
#pragma unroll
                    for (int n = 0; n < 2; ++n) asm volatile("" :: "v"(acc[a][b][m][n]));
    }
};
template <class F>
__device__ __forceinline__ void run_gemm(LAS unsigned char* lds, const pg8::Gemm& g, const F& f, const float* ssq_in, float* ssq_out) {
    pg8::StaticOrder S; S.init(g.nM, g.nN, (int)gridDim.x, obid());
    EpiWrap<F> E{f, ssq_in, ssq_out};
    if (PROBE_GEMM2) { EpiNull N; pg8::gemm_phase<EpiNull>(lds, g, S, N); }
    pg8::gemm_phase<EpiWrap<F>>(lds, g, S, E);
}

__global__ void __launch_bounds__(NTHR, 2) mega(Args a0) {
    extern __shared__ __attribute__((aligned(16))) unsigned char lds_raw[];
    LAS unsigned char* lds = (LAS unsigned char*)lds_raw;
    cg::grid_group grid = cg::this_grid();
    volatile LAS unsigned* misc = (volatile LAS unsigned*)(lds + 131072 + 320);
    if (threadIdx.x < 32) misc[threadIdx.x] = 0u;
    __syncthreads();
    XcdBarrier xbar = xcd_barrier_post((unsigned*)(a0.ws + WS_CTL), misc + 8);
    int k = 0; const int plo = a0.lo, phi = a0.hi;
#define PH(...) do { if (k >= plo && k < phi) { ArgsR a = *opaque_args(); float* X = a.out; bf16_t* XB = WSB(WS_XB); float* SSQ = WSF(WS_SSQ); (void)X; (void)XB; (void)SSQ; __VA_ARGS__; if (k + 1 < phi) { if (phi > NPHASES) grid.sync(); else xcd_barrier(xbar); if (PROBE_SYNC2) xcd_barrier(xbar); } } ++k; } while (0)
    PH( prologue_weights(a, lds); if (PROBE_PRO2) { __syncthreads(); prologue_weights(a, lds); } s5_gen(a, lds, 0); if (PROBE_GEN2) s5_gen(a, lds, 0); );
#pragma nounroll
    for (int li = 0; li < 4; ++li) {
        const int kind = li % 3, j = li / 3;
        if (kind == 0) {
            PH( s5_u_phase(a, li, j); if (PROBE_EW2) s5_u_phase(a, li, j); );
            PH( REP(4) { pg8::Gemm g{A2, WSB(WS_AR + AR_S5A), 384, 256, 256, 256, 1, BIG, 0, 4, 65536}; run_gemm(lds, g, F_S5A{WSF(WS_AR + AR_HLOC)}, nullptr, nullptr); } );
            PH( s5_carry_phase(a, j); if (PROBE_EW2) s5_carry_phase(a, j); );
            PH( REP(4) { pg8::Gemm g{A2, WSB(WS_AR + AR_S5C), 384, 384, 384, 256, 1, BIG, 0, 4, 98304}; run_gemm(lds, g, F_S5C{A2, a.in[I_S5D] + j * 1024, YB}, nullptr, nullptr); } );
            PH( REP(32) { const bf16_t* W = WSB(WS_WGLU) + (size_t)j * 2048 * 1024; pg8::Gemm g{YB, W, 1024, 1024, 1024, 64, 8, BIG, 0, BIG, 0}; F_GLU f{X, XB, (PROBE_PH & 32) && rp_ == 0, li == 0 ? a.in[I_XP] : X, li == 0 ? a.in[I_XS] : X + (size_t)MP * D};
                  run_gemm(lds, g, f, nullptr, SSQ); sample_gemm(lds, YB + (size_t)MP * D, 1024, W, 1024, 32, 1024, MP, f, nullptr, SSQ); } );
        } else if (kind == 1) {
            PH( rw1_phase(a, li); if (PROBE_EW2) rw1_phase(a, li); );
            PH( REP(2) { pg8::Gemm g{HX, WSB(WS_WRW2), 2048, 2048, 2048, 64, 13, BIG, 0, BIG, 0}; F_RW2 f{RKV, LORA};
                  run_gemm(lds, g, f, nullptr, nullptr); sample_gemm(lds, HX + (size_t)MP * 2048, 2048, WSB(WS_WRW2), 2048, 104, 2048, MP, f, nullptr, nullptr, BIG, 0, 832 % (int)gridDim.x);
                  if (rp_ == 0) { const int w0 = 832 % (int)gridDim.x; if (obid() >= w0) convert_items(a, lds, (obid() - w0) * 8 + (otid() >> 6), ((int)gridDim.x - w0) * 8, 1); } } );
            PH( REP(2) { pg8::Gemm g{LORA, WSB(WS_WRW3), 256, 256, 256, 64, 12, BIG, 0, BIG, 0}; F_RW3 f{a.in[I_RWW0], a.in[I_RWA0], WSB(WS_AR + AR_DEC), WSB(WS_AR + AR_AA), WSB(WS_AR + AR_GG)};
                  run_gemm(lds, g, f, nullptr, nullptr); sample_gemm(lds, LORA + (size_t)MP * 256, 256, WSB(WS_WRW3), 256, 96, 256, MP, f, nullptr, nullptr); } );
            PH( rw4_phase(a, lds); );
            PH( rw4b_phase(a, lds); );
            PH( REP(32) { pg8::Gemm g{RKV, WSB(WS_WRWO), 1024, 1024, 1024, 64, 4, BIG, 0, BIG, 0}; F_RES f{X, XB, (PROBE_PH & 32) && rp_ == 0};
                  run_gemm(lds, g, f, nullptr, SSQ); sample_gemm(lds, RKV + (size_t)MP * D, 1024, WSB(WS_WRWO), 1024, 32, 1024, MP, f, nullptr, SSQ); } );
        } else {
            PH( REP(8) { pg8::Gemm g{XB, WSB(WS_WLIN), 1024, 1024, 1024, 64, 8, BIG, 0, BIG, 0}; F_LRUIN f{GATE, UPRE};
                  run_gemm(lds, g, f, SSQ, nullptr); sample_gemm(lds, XB + (size_t)MP * D, 1024, WSB(WS_WLIN), 1024, 32, 1024, MP, f, SSQ, nullptr); } );
            PH( lru_conv_phase(a); if (PROBE_EW2) lru_conv_phase(a); );
            PH( REP(8) { pg8::Gemm g{U_, WSB(WS_WRGIG), 1024, 256, 256, 64, 8, 2, 256, BIG, 0}; F_RGIG f{a.in[I_LBRG], a.in[I_LBIG], WSF(WS_LSL), U_, WSF(WS_AR + AR_AF), WSB(WS_AR + AR_BX)};
                  run_gemm(lds, g, f, nullptr, nullptr); sample_gemm(lds, U_ + (size_t)MP * D, 1024, WSB(WS_WRGIG), 256, 32, 256, MP, f, nullptr, nullptr, 8, 256); } );
            PH( lru_scan_fused(a, lds); );
            PH( REP(32) { pg8::Gemm g{GATE, WSB(WS_WLOUT), 1024, 1024, 1024, 64, 4, BIG, 0, BIG, 0}; F_RES f{X, XB, (PROBE_PH & 32) && rp_ == 0};
                  run_gemm(lds, g, f, nullptr, SSQ); sample_gemm(lds, GATE + (size_t)MP * D, 1024, WSB(WS_WLOUT), 1024, 32, 1024, MP, f, nullptr, SSQ); } );
        }
        PH( REP(1) { const bf16_t* W = WSB(WS_WFIN) + (size_t)li * 5632 * 1024; pg8::Gemm g{XB, W, 1024, 1024, 1024, 64, 22, BIG, 0, BIG, 0};
              const float* cw = a.in[I_FCW] + (size_t)li * 3 * FF; const float* cb = a.in[I_FCB] + (size_t)li * FF; float* HALO = WSF(WS_AR + AR_G);
              { pg8::StaticOrder S; S.init(64, 22, (int)gridDim.x, obid());
                EpiFFN E{UP_, HALO, HALO + 64 * 2 * FF, HALO + 2 * 64 * 2 * FF, SSQ, cw, cb, a.out + O_FC_P + (size_t)li * 8 * 2 * FF, (LAS float*)(lds + 131072 + 1024)};
                pg8::gemm_phase<EpiFFN>(lds, g, S, E); }
              F_FFNIN_S fs{UP_, a.in[I_FC] + (size_t)li * 128 * 2 * FF, a.out + O_FC_S + (size_t)li * 128 * 2 * FF, cw, cb};
              sample_gemm(lds, XB + (size_t)MP * D, 1024, W, 1024, 88, 1024, MP, fs, SSQ, nullptr, BIG, 0, 1408 % (int)gridDim.x);
              if (li == 2) s5_gen(a, lds, 1); } );
        PH( REP(16) { const bf16_t* W = WSB(WS_WFOUT) + (size_t)li * 1024 * 2816; pg8::Gemm g{UP_, W, 2816, 2816, 2816, 64, 4, BIG, 0, BIG, 0}; F_RES f{X, XB, (PROBE_PH & 16) && rp_ == 0};
              ffn_fix(a, li);
              run_gemm(lds, g, f, nullptr, SSQ); sample_gemm(lds, UP_ + (size_t)MP * FF, 2816, W, 2816, 32, 2816, MP, f, nullptr, SSQ); } );
    }
    PH( final_phase(a); );
#undef PH
}

extern "C" void kernel_launch(void* const* d_in, const int* in_sizes, int n_in, void* d_out, int out_size, void* d_ws, size_t ws_size, hipStream_t stream) {
    static int grid = 0;
    if (grid == 0) {
        if (n_in != 50 || (size_t)out_size != O_END || ws_size < WS_END) {
            fprintf(stderr, "kernel_launch: unexpected shapes: n_in %d out %d ws %zu (need %zu)\n", n_in, out_size, ws_size, (size_t)WS_END); grid = -1; return; }
        int dev = 0, cus = 0, per_cu = 0;
        hipGetDevice(&dev); hipDeviceGetAttribute(&cus, hipDeviceAttributeMultiprocessorCount, dev);
        if (hipFuncSetAttribute((const void*)mega, hipFuncAttributeMaxDynamicSharedMemorySize, LDS_BYTES) != hipSuccess) { fprintf(stderr, "kernel_launch: hipFuncSetAttribute failed\n"); grid = -1; return; }
        if (hipOccupancyMaxActiveBlocksPerMultiprocessor(&per_cu, (const void*)mega, NTHR, LDS_BYTES) != hipSuccess || per_cu < 1) { fprintf(stderr, "kernel_launch: occupancy query says %d\n", per_cu); per_cu = 1; }
        (void)hipGetLastError();
        grid = cus * per_cu;
        fprintf(stderr, "kernel_launch: grid %d (cus %d x %d)\n", grid, cus, per_cu);
    }
    if (grid < 0) return;
    Args a{};
    for (int i = 0; i < 50; ++i) a.in[i] = (const float*)d_in[i];
    a.out = (float*)d_out; a.ws = (unsigned char*)d_ws;
#if PER_PHASE_LAUNCH
    for (int k = 0; k < NPHASES; ++k) { a.lo = k; a.hi = k + 1; hipLaunchKernelGGL(mega, dim3(grid), dim3(NTHR), LDS_BYTES, stream, a); }
#else
    if (hipMemsetAsync((char*)d_ws + WS_CTL, 0, XCD_BAR_WORDS * 4, stream) != hipSuccess) { fprintf(stderr, "kernel_launch: memset failed\n"); return; }
    a.lo = 0; a.hi = NPHASES; void* args[] = {&a};
    hipError_t e = hipLaunchCooperativeKernel((const void*)mega, dim3(grid), dim3(NTHR), args, LDS_BYTES, stream);
    if (e != hipSuccess) fprintf(stderr, "cooperative launch failed: %s (grid %d)\n", hipGetErrorString(e), grid);
#endif
}
```

```cpp
#include <hip/hip_runtime.h>
#include <hip/hip_cooperative_groups.h>
#include <cstdio>
#include <cstdint>
namespace cg = cooperative_groups;

#define PROBE_SYNC2 0
#define PROBE_PH 0
#define REP(bit) for (int rp_ = 0; rp_ < ((PROBE_PH & (bit)) ? 2 : 1); ++rp_)
#define PROBE_GEMM2 0
#define PROBE_RW4 0
#define PROBE_EW2 0
#define PROBE_PRO2 0
#define PROBE_CONV2 0
#define PROBE_MISC2 0
#define PROBE_GEN2 0
#define PROBE_SG2 0
#define PROBE_EPI2 0
#ifndef PER_PHASE_LAUNCH
#define PER_PHASE_LAUNCH 0
#endif

#define LAS __attribute__((address_space(3)))
typedef unsigned short bf16_t;
typedef short bf16x8 __attribute__((ext_vector_type(8)));
typedef float f32x4 __attribute__((ext_vector_type(4)));
typedef float f32x2 __attribute__((ext_vector_type(2)));
typedef float f32x16 __attribute__((ext_vector_type(16)));
typedef unsigned u32x4 __attribute__((ext_vector_type(4)));
typedef unsigned u32x2 __attribute__((ext_vector_type(2)));

constexpr int D = 1024, LSEQ = 2048, NB = 8, MP = NB * LSEQ, MS = 128, MA = MP + MS, FF = 2816;
constexpr float RMS_EPS = 1e-6f;
constexpr size_t O_Y = 0;
constexpr size_t O_S5RE_P = (size_t)MA * D;
constexpr size_t O_S5RE_S = O_S5RE_P + 2 * 8 * 4096;
constexpr size_t O_S5IM_P = O_S5RE_S + 2 * 128 * 4096;
constexpr size_t O_S5IM_S = O_S5IM_P + 2 * 8 * 4096;
constexpr size_t O_WKV_P = O_S5IM_S + 2 * 128 * 4096;
constexpr size_t O_WKV_S = O_WKV_P + 8 * 16 * 4096;
constexpr size_t O_SH_P = O_WKV_S + (size_t)128 * 16 * 4096;
constexpr size_t O_SH_S = O_SH_P + 8 * 1024;
constexpr size_t O_LH_P = O_SH_S + 128 * 1024;
constexpr size_t O_LH_S = O_LH_P + 8 * 1024;
constexpr size_t O_LC_P = O_LH_S + 128 * 1024;
constexpr size_t O_LC_S = O_LC_P + 8 * 3 * 1024;
constexpr size_t O_FC_P = O_LC_S + 128 * 3 * 1024;
constexpr size_t O_FC_S = O_FC_P + 4 * 8 * 2 * FF;
constexpr size_t O_END = O_FC_S + (size_t)4 * 128 * 2 * FF;
static_assert(O_END == 31809536, "output size");

constexpr size_t MiB = 1u << 20;
constexpr size_t WS_WGLU = 0, WS_WFIN = 8 * MiB, WS_WFOUT = 52 * MiB, WS_WRW2 = 74 * MiB, WS_WRW3 = 87 * MiB, WS_WRWO = 89 * MiB,
                 WS_WLIN = 91 * MiB, WS_WRGIG = 95 * MiB, WS_WLOUT = 96 * MiB, WS_TBL = 98 * MiB, WS_LSL = 98 * MiB + 512 * 1024,
                 WS_CAR = 99 * MiB, WS_CTL = 101 * MiB, WS_XB = 102 * MiB, WS_SSQ = 135 * MiB, WS_AR = 138 * MiB, WS_END = WS_AR + 204 * MiB;
constexpr size_t AR_G = 0, AR_UP = 89 * MiB;
constexpr size_t AR_A2 = 0, AR_HLOC = 48 * MiB, AR_YB = 80 * MiB;
constexpr size_t AR_S5A = 180 * MiB, AR_S5C = 188 * MiB;
constexpr size_t AR_HX = 0, AR_DEC = 0, AR_AA = 32 * MiB + 512 * 1024, AR_RKV = 65 * MiB, RKV_PLANE = 32 * MiB + 512 * 1024,
                 AR_LORA = AR_RKV + 3 * RKV_PLANE, AR_GG = AR_LORA + 8 * MiB + 512 * 1024;
constexpr size_t AR_GATE = 0, AR_UPRE = 32 * MiB + 512 * 1024, AR_U = 65 * MiB, AR_AF = 97 * MiB + 512 * 1024,
                 AR_BX = 162 * MiB + 512 * 1024;
static_assert(AR_GG + 32 * MiB + 512 * 1024 <= 204 * MiB && AR_BX + 32 * MiB + 512 * 1024 <= 204 * MiB, "arena");

__device__ __forceinline__ int otid() { int t = threadIdx.x; asm volatile("" : "+v"(t)); return t; }
__device__ __forceinline__ int obid() { int t = blockIdx.x; asm volatile("" : "+s"(t)); return t; }

__device__ __forceinline__ unsigned f2bf(float f) { unsigned u = __builtin_bit_cast(unsigned, f); return (u + 0x7fffu + ((u >> 16) & 1u)) >> 16; }
__device__ __forceinline__ unsigned pk2(float lo, float hi) { return f2bf(lo) | (f2bf(hi) << 16); }
__device__ __forceinline__ float bflo(unsigned w) { return __uint_as_float(w << 16); }
__device__ __forceinline__ float bfhi(unsigned w) { return __uint_as_float(w & 0xffff0000u); }
__device__ __forceinline__ float bf1(bf16_t b) { return __uint_as_float((unsigned)b << 16); }
__device__ __forceinline__ u32x2 pk4(f32x4 v) { u32x2 r; r.x = pk2(v[0], v[1]); r.y = pk2(v[2], v[3]); return r; }
__device__ __forceinline__ f32x4 unpk4(u32x2 w) { return (f32x4){bflo(w.x), bfhi(w.x), bflo(w.y), bfhi(w.y)}; }
__device__ __forceinline__ float sigmoidf_(float x) { return 1.f / (1.f + __expf(-x)); }
__device__ __forceinline__ float gelu_tanh(float x) { const float z = 0.7978845608f * (x + 0.044715f * x * x * x); return x / (1.f + __expf(-2.f * z)); }
__device__ __forceinline__ float tanhf_(float x) { return 1.f - 2.f / (__expf(2.f * x) + 1.f); }
__device__ __forceinline__ float wave_sum(float v) {
#pragma unroll
    for (int o = 1; o < 64; o <<= 1) v += __shfl_xor(v, o);
    return v;
}
template <int CTRL> __device__ __forceinline__ float dppf(float x) {
    return __builtin_bit_cast(float, __builtin_amdgcn_update_dpp(0, __builtin_bit_cast(int, x), CTRL, 0xf, 0xf, true));
}
__device__ __forceinline__ float row16_sum(float x) {
    x += dppf<0xB1>(x);
    x += dppf<0x4E>(x);
    x += dppf<0x141>(x);
    x += dppf<0x140>(x);
    return x;
}

namespace pg8 {
constexpr int BM = 256, BK = 64, HALF = 128, HTB = HALF * BK * 2, STAGE_BYTES = 8 * HTB, NXCD = 8, WGM = 8;
__host__ __device__ __forceinline__ int lds_byte(int r, int c) { const int st = (r >> 4) * 2 + (c >> 5), rr = r & 15, cc = c & 31, ob = rr * 64 + cc * 2; return st * 1024 + (ob ^ (((ob >> 9) & 1) << 5)); }
__host__ __device__ __forceinline__ void stage_rc(int b, int& R, int& C) { const int st = b / 1024, sb = b % 1024, swz = sb ^ (((sb >> 9) & 1) << 5); R = (st >> 1) * 16 + swz / 64; C = (st & 1) * 32 + (swz % 64) / 2; }
__host__ __device__ __forceinline__ int perm32(int rho) { const int n = rho >> 4, i = rho & 15; return 8 * (i >> 2) + 4 * n + (i & 3); }

struct Unit { int pm, pn; };
struct Gemm { const bf16_t* A; const bf16_t* Bt; int lda, ldb, K, nM, nN; int a_ndiv; int a_nstride; int b_mdiv; int b_mstride; };
__device__ __forceinline__ const char* a_base(const Gemm& g, const Unit& u) { return (const char*)(g.A + (size_t)u.pm * 256 * g.lda + (size_t)(u.pn / g.a_ndiv) * g.a_nstride); }
__device__ __forceinline__ const char* b_base(const Gemm& g, const Unit& u) { return (const char*)(g.Bt + (size_t)u.pn * 256 * g.ldb + (size_t)(u.pm / g.b_mdiv) * g.b_mstride); }

struct StaticOrder {
    int nM, nN, nwg, G, c;
    __device__ void init(int nM_, int nN_, int G_, int c_) { nM = nM_; nN = nN_; nwg = nM * nN; G = G_; c = c_; }
    __device__ bool next(int i, Unit& u) const {
        const long L = (long)i * G + c; if (L >= nwg) return false;
        int wgid = (int)L; { const int q = nwg / NXCD, r = nwg % NXCD, xcd = wgid % NXCD, off = wgid / NXCD; wgid = (xcd < r ? xcd * (q + 1) : r * (q + 1) + (xcd - r) * q) + off; }
        const int nig = WGM * nN, gid = wgid / nig, fm = gid * WGM, gsz = (nM - fm) < WGM ? (nM - fm) : WGM;
        u.pm = fm + ((wgid % nig) % gsz); u.pn = (wgid % nig) / gsz; return true;
    }
};

template <class Epi>
__device__ __forceinline__ void gemm_phase(LAS unsigned char* lds, const Gemm g, const StaticOrder& S, const Epi& E) {
    const int tid = otid(), wid = __builtin_amdgcn_readfirstlane(tid >> 6), lane = tid & 63, wr = wid >> 2, wc = wid & 3, fr = lane & 15, fq = lane >> 4;
    const int K = g.K, nt = K / BK;
    unsigned voffA[2], voffB[2];
#pragma unroll
    for (int i = 0; i < 2; ++i) { int R, C; stage_rc(tid * 16 + i * 8192, R, C); const int Rb = (R & ~31) + perm32(R & 31);
        voffA[i] = (unsigned)(R * g.lda + C) * 2u; voffB[i] = (unsigned)(Rb * g.ldb + C) * 2u; }
    const size_t kstep = (size_t)(BK * 2);
    const size_t hstepA = (size_t)HALF * g.lda * 2, hstepB = (size_t)HALF * g.ldb * 2;
    const unsigned ldsw = (unsigned)wid * 1024u;
    const int aoff = lds_byte(wr * 64 + fr, fq * 8), boff = lds_byte(wc * 32 + fr, fq * 8);
#define PG8_SA(b, h) (((b) * 2 + (h)) * HTB)
#define PG8_SB(b, h) ((4 + (b) * 2 + (h)) * HTB)
#define PG8_STAGE(bufoff, gbase, voff) do { _Pragma("unroll") for (int _i = 0; _i < 2; ++_i) \
        __builtin_amdgcn_global_load_lds((const unsigned*)((const char*)(gbase) + (voff)[_i]), (LAS unsigned*)(lds + (bufoff) + ldsw + _i * 8192), 16, 0, 0); } while (0)
#define PG8_LDA(dst, b, h) do { _Pragma("unroll") for (int m = 0; m < 4; ++m) _Pragma("unroll") for (int k = 0; k < 2; ++k) dst[m][k] = *(const LAS bf16x8*)(lds + PG8_SA(b, h) + aoff + m * 2048 + k * 1024); } while (0)
#define PG8_LDB(dst, b, h) do { _Pragma("unroll") for (int n = 0; n < 2; ++n) _Pragma("unroll") for (int k = 0; k < 2; ++k) dst[n][k] = *(const LAS bf16x8*)(lds + PG8_SB(b, h) + boff + n * 2048 + k * 1024); } while (0)
#define PG8_MMA(ai, bj, At, Bt) do { __builtin_amdgcn_s_setprio(1); _Pragma("unroll") for (int m = 0; m < 4; ++m) _Pragma("unroll") for (int n = 0; n < 2; ++n) _Pragma("unroll") for (int k = 0; k < 2; ++k) \
        acc[ai][bj][m][n] = __builtin_amdgcn_mfma_f32_16x16x32_bf16(Bt[n][k], At[m][k], acc[ai][bj][m][n], 0, 0, 0); __builtin_amdgcn_s_setprio(0); } while (0)
#define PG8_WAIT_V(n) asm volatile("s_waitcnt vmcnt(" #n ")" ::: "memory")
#define PG8_WAIT_L(n) asm volatile("s_waitcnt lgkmcnt(" #n ")" ::: "memory")
#define PG8_BAR __builtin_amdgcn_s_barrier()
#define PG8_SCHED __builtin_amdgcn_sched_barrier(0)
    Unit cur, nxt; int ui = 0;
    if (!S.next(0, cur)) return;
    f32x4 acc[2][2][4][2];
#pragma unroll
    for (int a = 0; a < 2; ++a)
#pragma unroll
        for (int b = 0; b < 2; ++b)
#pragma unroll
            for (int m = 0; m < 4; ++m)
#pragma unroll
                for (int n = 0; n < 2; ++n) acc[a][b][m][n] = (f32x4){0.f, 0.f, 0.f, 0.f};
    bf16x8 At[4][2], B0[2][2], B1[2][2];
    const char* cA = a_base(g, cur); const char* cB = b_base(g, cur);
    PG8_STAGE(PG8_SB(0, 0), cB, voffB); PG8_STAGE(PG8_SB(0, 1), cB + hstepB, voffB); PG8_STAGE(PG8_SA(0, 0), cA, voffA); PG8_STAGE(PG8_SA(0, 1), cA + hstepA, voffA);
    if (wr == 1) PG8_BAR;
    PG8_WAIT_V(2); PG8_BAR;
    PG8_STAGE(PG8_SB(1, 0), cB + kstep, voffB); PG8_STAGE(PG8_SA(1, 0), cA + kstep, voffA); PG8_STAGE(PG8_SB(1, 1), cB + hstepB + kstep, voffB);
    PG8_WAIT_V(6); PG8_BAR;
    for (;;) {
        const bool has_next = S.next(ui + 1, nxt);
        const char* nA = has_next ? a_base(g, nxt) : cA; const char* nB = has_next ? b_base(g, nxt) : cB;
        for (int t = 0; t < nt; t += 2) {
            const bool last = (t == nt - 2);
            const char* a1 = cA + (size_t)(t + 1) * kstep;
            const char* a2 = last ? nA : cA + (size_t)(t + 2) * kstep; const char* b2 = last ? nB : cB + (size_t)(t + 2) * kstep;
            const char* a3 = a2 + kstep; const char* b3 = b2 + kstep;
            PG8_LDB(B0, 0, 0); PG8_LDB(B1, 0, 1); PG8_SCHED; PG8_LDA(At, 0, 0); PG8_STAGE(PG8_SA(1, 1), a1 + hstepA, voffA);
            PG8_WAIT_V(8); PG8_WAIT_L(0); PG8_BAR; PG8_MMA(0, 0, At, B0); PG8_MMA(0, 1, At, B1); PG8_BAR; PG8_SCHED;
            PG8_LDA(At, 0, 1); PG8_STAGE(PG8_SB(0, 0), b2, voffB); PG8_STAGE(PG8_SB(0, 1), b2 + hstepB, voffB); PG8_STAGE(PG8_SA(0, 0), a2, voffA);
            PG8_WAIT_V(8); PG8_WAIT_L(0); PG8_BAR; PG8_MMA(1, 0, At, B0); PG8_MMA(1, 1, At, B1); PG8_BAR; PG8_SCHED;
            PG8_LDB(B0, 1, 0); PG8_LDB(B1, 1, 1); PG8_SCHED; PG8_LDA(At, 1, 0); PG8_STAGE(PG8_SA(0, 1), a2 + hstepA, voffA);
            PG8_WAIT_V(8); PG8_WAIT_L(0); PG8_BAR; PG8_MMA(0, 0, At, B0); PG8_MMA(0, 1, At, B1); PG8_BAR; PG8_SCHED;
            PG8_LDA(At, 1, 1); PG8_STAGE(PG8_SB(1, 0), b3, voffB); PG8_STAGE(PG8_SB(1, 1), b3 + hstepB, voffB); PG8_STAGE(PG8_SA(1, 0), a3, voffA);
            PG8_WAIT_V(8); PG8_WAIT_L(0); PG8_BAR; PG8_MMA(1, 0, At, B0); PG8_MMA(1, 1, At, B1); PG8_BAR; PG8_SCHED;
        }
        if (wr == 0) PG8_BAR;
        E(acc, cur, wr, wc, fr, fq);
        if (PROBE_EPI2 && Epi::IDEMP) E(acc, cur, wr, wc, fr, fq);
        if (!has_next) break;
#pragma unroll
        for (int a = 0; a < 2; ++a)
#pragma unroll
            for (int b = 0; b < 2; ++b)
#pragma unroll
                for (int m = 0; m < 4; ++m)
#pragma unroll
                    for (int n = 0; n < 2; ++n) acc[a][b][m][n] = (f32x4){0.f, 0.f, 0.f, 0.f};
        cur = nxt; cA = nA; cB = nB; ++ui;
        if (wr == 1) PG8_BAR;
    }
    PG8_WAIT_V(0);
    PG8_BAR;
#undef PG8_SA
#undef PG8_SB
#undef PG8_STAGE
#undef PG8_LDA
#undef PG8_LDB
#undef PG8_MMA
#undef PG8_WAIT_V
#undef PG8_WAIT_L
#undef PG8_BAR
#undef PG8_SCHED
}
}

__device__ __forceinline__ float rstd_from(float s) { return 1.f / sqrtf(s * (1.f / D) + RMS_EPS); }

struct NoPre {};
template <class F> struct EpiWrap {
    static constexpr bool IDEMP = !F::HAS_SSQ;
    F f; const float* ssq_in; float* ssq_out;
    __device__ __forceinline__ void operator()(const f32x4 (&acc)[2][2][4][2], const pg8::Unit& u, int wr, int wc, int fr, int fq) const {
        const f32x4 z = {0.f, 0.f, 0.f, 0.f};
        constexpr int NCG = F::PAIRED ? 1 : 2;
        int colg[NCG]; typename F::CP cp[NCG];
#pragma unroll
        for (int c = 0; c < NCG; ++c) { colg[c] = F::PAIRED ? u.pn * 128 + wc * 32 + fq * 8 : u.pn * 256 + c * 128 + wc * 32 + fq * 8; cp[c] = f.cpre(u.pm * 256, colg[c]); }
#pragma unroll
        for (int ai = 0; ai < 2; ++ai) {
            typename F::RP rp[4][NCG]; f32x4 sa[4], sb[4];
#pragma unroll
            for (int m = 0; m < 4; ++m) {
                const int row = u.pm * 256 + ai * 128 + wr * 64 + m * 16 + fr;
                if (F::NEED_RSTD) { sa[m] = *(const f32x4*)(ssq_in + (size_t)row * 32 + fq * 8); sb[m] = *(const f32x4*)(ssq_in + (size_t)row * 32 + fq * 8 + 4); }
#pragma unroll
                for (int c = 0; c < NCG; ++c) rp[m][c] = f.rpre(row, colg[c]);
            }
#pragma unroll
            for (int m = 0; m < 4; ++m) {
                const int row = u.pm * 256 + ai * 128 + wr * 64 + m * 16 + fr;
                float rs = 1.f;
                if (F::NEED_RSTD) { float s = (sa[m][0] + sa[m][1]) + (sa[m][2] + sa[m][3]) + (sb[m][0] + sb[m][1]) + (sb[m][2] + sb[m][3]); s += __shfl_xor(s, 16); s += __shfl_xor(s, 32); rs = rstd_from(s); }
                if (F::PAIRED) {
                    float q = f.fin(row, colg[0], acc[ai][0][m][0], acc[ai][0][m][1], acc[ai][1][m][0], acc[ai][1][m][1], rs, cp[0], rp[m][0]);
                    if (F::HAS_SSQ) { q += __shfl_xor(q, 16); q += __shfl_xor(q, 32); if (fq == 0) ssq_out[(size_t)row * 32 + u.pn * 4 + wc] = q; }
                } else {
#pragma unroll
                    for (int bj = 0; bj < 2; ++bj) {
                        float q = f.fin(row, colg[bj], acc[ai][bj][m][0], acc[ai][bj][m][1], z, z, rs, cp[bj], rp[m][bj]);
                        if (F::HAS_SSQ) { q += __shfl_xor(q, 16); q += __shfl_xor(q, 32); if (fq == 0) ssq_out[(size_t)row * 32 + u.pn * 8 + bj * 4 + wc] = q; }
                    }
                }
            }
        }
    }
};
__device__ __forceinline__ u32x4 pk8(f32x4 a, f32x4 b) { u32x4 r; r.x = pk2(a[0], a[1]); r.y = pk2(a[2], a[3]); r.z = pk2(b[0], b[1]); r.w = pk2(b[2], b[3]); return r; }
__device__ __forceinline__ float ssq4(f32x4 x) { return (x[0] * x[0] + x[1] * x[1]) + (x[2] * x[2] + x[3] * x[3]); }
#define UNPK8(WW_, lo, hi) const f32x4 lo = {bflo((WW_)[0]), bfhi((WW_)[0]), bflo((WW_)[1]), bfhi((WW_)[1])}, hi = {bflo((WW_)[2]), bfhi((WW_)[2]), bflo((WW_)[3]), bfhi((WW_)[3])}
struct X8 { f32x4 x0, x1; };
struct U8 { u32x4 w; };
struct C24 { f32x4 a0, a1, b0, b1, c0, c1; };

struct F_RES {
    static constexpr bool PAIRED = false, NEED_RSTD = false, HAS_SSQ = true;
    typedef NoPre CP; typedef X8 RP;
    float* X; bf16_t* XB; bool dry = false;
    __device__ __forceinline__ CP cpre(int, int) const { return CP{}; }
    __device__ __forceinline__ RP rpre(int row, int col) const { const float* xp = X + (size_t)row * D + col; return RP{*(const f32x4*)xp, *(const f32x4*)(xp + 4)}; }
    __device__ __forceinline__ float fin(int row, int col, f32x4 a0, f32x4 a1, f32x4, f32x4, float, const CP&, const RP& r) const {
        float* xp = X + (size_t)row * D + col; const f32x4 x0 = r.x0 + a0, x1 = r.x1 + a1; *(f32x4*)xp = dry ? r.x0 : x0; *(f32x4*)(xp + 4) = dry ? r.x1 : x1;
        *(u32x4*)(XB + (size_t)row * D + col) = pk8(x0, x1); return ssq4(x0) + ssq4(x1);
    }
};
struct F_GLU {
    static constexpr bool PAIRED = true, NEED_RSTD = false, HAS_SSQ = true;
    typedef NoPre CP; typedef X8 RP;
    float* X; bf16_t* XB; bool dry = false; const float* Xp = nullptr; const float* Xs = nullptr;
    __device__ __forceinline__ CP cpre(int, int) const { return CP{}; }
    __device__ __forceinline__ RP rpre(int row, int col) const { const float* xp = (row < MP ? Xp + (size_t)row * D : Xs + (size_t)(row - MP) * D) + col; return RP{*(const f32x4*)xp, *(const f32x4*)(xp + 4)}; }
    __device__ __forceinline__ float fin(int row, int col, f32x4 a0, f32x4 a1, f32x4 b0, f32x4 b1, float, const CP&, const RP& r) const {
        float* xp = X + (size_t)row * D + col; f32x4 x0 = r.x0, x1 = r.x1;
#pragma unroll
        for (int e = 0; e < 4; ++e) { x0[e] += a0[e] * sigmoidf_(b0[e]); x1[e] += a1[e] * sigmoidf_(b1[e]); }
        *(f32x4*)xp = dry ? r.x0 : x0; *(f32x4*)(xp + 4) = dry ? r.x1 : x1; *(u32x4*)(XB + (size_t)row * D + col) = pk8(x0, x1); return ssq4(x0) + ssq4(x1);
    }
};
struct F_FFNIN {
    static constexpr bool PAIRED = true, NEED_RSTD = true, HAS_SSQ = false;
    typedef NoPre CP; typedef NoPre RP;
    bf16_t* G; bf16_t* UP;
    __device__ __forceinline__ CP cpre(int, int) const { return CP{}; }
    __device__ __forceinline__ RP rpre(int, int) const { return RP{}; }
    __device__ __forceinline__ float fin(int row, int col, f32x4 a0, f32x4 a1, f32x4 b0, f32x4 b1, float rs, const CP&, const RP&) const {
        *(u32x4*)(G + (size_t)row * FF + col) = pk8(a0 * rs, a1 * rs); *(u32x4*)(UP + (size_t)row * FF + col) = pk8(b0 * rs, b1 * rs); return 0.f;
    }
};
struct F_LRUIN {
    static constexpr bool PAIRED = true, NEED_RSTD = true, HAS_SSQ = false;
    typedef NoPre CP; typedef NoPre RP;
    bf16_t* GATEp; bf16_t* UPREp;
    __device__ __forceinline__ CP cpre(int, int) const { return CP{}; }
    __device__ __forceinline__ RP rpre(int, int) const { return RP{}; }
    __device__ __forceinline__ float fin(int row, int col, f32x4 a0, f32x4 a1, f32x4 b0, f32x4 b1, float rs, const CP&, const RP&) const {
        f32x4 g0, g1;
#pragma unroll
        for (int e = 0; e < 4; ++e) { g0[e] = gelu_tanh(a0[e] * rs); g1[e] = gelu_tanh(a1[e] * rs); }
        *(u32x4*)(GATEp + (size_t)row * D + col) = pk8(g0, g1); *(u32x4*)(UPREp + (size_t)row * D + col) = pk8(b0 * rs, b1 * rs); return 0.f;
    }
};
struct F_RGIG {
    static constexpr bool PAIRED = true, NEED_RSTD = false, HAS_SSQ = false;
    typedef C24 CP; typedef U8 RP;
    const float* brg; const float* big; const float* lsl; const bf16_t* U; float* AF; bf16_t* BX;
    __device__ __forceinline__ CP cpre(int, int col) const { return CP{*(const f32x4*)(brg + col), *(const f32x4*)(brg + col + 4), *(const f32x4*)(big + col), *(const f32x4*)(big + col + 4), *(const f32x4*)(lsl + col), *(const f32x4*)(lsl + col + 4)}; }
    __device__ __forceinline__ RP rpre(int row, int col) const { return RP{*(const u32x4*)(U + (size_t)row * D + col)}; }
    __device__ __forceinline__ void half(f32x4 b0, f32x4 b1, f32x4 ls, f32x4 v0, f32x4 v1, f32x4 uu, f32x4& a, f32x4& bx) const {
#pragma unroll
        for (int e = 0; e < 4; ++e) { const float rg = sigmoidf_(v0[e] + b0[e]), ig = sigmoidf_(v1[e] + b1[e]); const float la = rg * ls[e];
            a[e] = __expf(la); const float m2 = 1.f - __expf(2.f * la); bx[e] = sqrtf(m2 > 0.f ? m2 : 0.f) * ig * uu[e]; }
    }
    __device__ __forceinline__ float fin(int row, int col, f32x4 a0, f32x4 a1, f32x4 b0, f32x4 b1, float, const CP& c, const RP& r) const {
        UNPK8(r.w, u0, u1); f32x4 r0, r1, x0, x1;
        half(c.a0, c.b0, c.c0, a0, b0, u0, r0, x0); half(c.a1, c.b1, c.c1, a1, b1, u1, r1, x1);
        *(f32x4*)(AF + (size_t)row * D + col) = r0; *(f32x4*)(AF + (size_t)row * D + col + 4) = r1; *(u32x4*)(BX + (size_t)row * D + col) = pk8(x0, x1); return 0.f;
    }
};
struct F_RW2 {
    static constexpr bool PAIRED = false, NEED_RSTD = false, HAS_SSQ = false;
    typedef NoPre CP; typedef NoPre RP;
    bf16_t* RKVp; bf16_t* LORAp;
    __device__ __forceinline__ CP cpre(int, int) const { return CP{}; }
    __device__ __forceinline__ RP rpre(int, int) const { return RP{}; }
    __device__ __forceinline__ float fin(int row, int col, f32x4 a0, f32x4 a1, f32x4, f32x4, float, const CP&, const RP&) const {
        if (col < 3072) { const int j = col >> 10, c = col & 1023; *(u32x4*)(RKVp + (size_t)j * (RKV_PLANE / 2) + (size_t)row * D + c) = pk8(a0, a1); }
        else { const int c = col - 3072; f32x4 o0, o1;
#pragma unroll
            for (int e = 0; e < 4; ++e) { o0[e] = c < 64 ? tanhf_(a0[e]) : (c < 128 ? a0[e] : sigmoidf_(a0[e])); o1[e] = c < 64 ? tanhf_(a1[e]) : (c < 128 ? a1[e] : sigmoidf_(a1[e])); }
            *(u32x4*)(LORAp + (size_t)row * 256 + c) = pk8(o0, o1); }
        return 0.f;
    }
};
struct F_RW3 {
    static constexpr bool PAIRED = false, NEED_RSTD = false, HAS_SSQ = false;
    typedef X8 CP; typedef NoPre RP;
    const float* w0; const float* a0p; bf16_t* DEC; bf16_t* AA; bf16_t* GG;
    __device__ __forceinline__ CP cpre(int, int col) const { const int j = col >> 10, c = col & 1023; const float* p = j == 0 ? w0 + c : a0p + c; if (j == 2) p = w0; return CP{*(const f32x4*)p, *(const f32x4*)(p + 4)}; }
    __device__ __forceinline__ RP rpre(int, int) const { return RP{}; }
    __device__ __forceinline__ f32x4 dec4(f32x4 w, f32x4 v) const { f32x4 o;
#pragma unroll
        for (int e = 0; e < 4; ++e) { const float z = w[e] + v[e]; const float wl = -__logf(1.f + __expf(-z)) - 0.5f; const float ew = __expf(wl); o[e] = ew < 1e-3f ? ew * (1.f - 0.5f * ew) : 1.f - __expf(-ew); }
        return o; }
    __device__ __forceinline__ f32x4 sig4(f32x4 w, f32x4 v) const { f32x4 o;
#pragma unroll
        for (int e = 0; e < 4; ++e) o[e] = sigmoidf_(w[e] + v[e]);
        return o; }
    __device__ __forceinline__ float fin(int row, int col, f32x4 a0, f32x4 a1, f32x4, f32x4, float, const CP& cp, const RP&) const {
        const int j = col >> 10, c = col & 1023;
        if (j == 0) *(u32x4*)(DEC + (size_t)row * D + c) = pk8(dec4(cp.x0, a0), dec4(cp.x1, a1));
        else if (j == 1) *(u32x4*)(AA + (size_t)row * D + c) = pk8(sig4(cp.x0, a0), sig4(cp.x1, a1));
        else *(u32x4*)(GG + (size_t)row * D + c) = pk8(a0, a1);
        return 0.f;
    }
};
struct F_S5A {
    static constexpr bool PAIRED = false, NEED_RSTD = false, HAS_SSQ = false;
    typedef NoPre CP; typedef NoPre RP;
    float* HLOC;
    __device__ __forceinline__ CP cpre(int, int) const { return CP{}; }
    __device__ __forceinline__ RP rpre(int, int) const { return RP{}; }
    __device__ __forceinline__ float fin(int row, int col, f32x4 a0, f32x4 a1, f32x4, f32x4, float, const CP&, const RP&) const {
        if (col < 128) { *(f32x4*)(HLOC + (size_t)row * 128 + col) = a0; *(f32x4*)(HLOC + (size_t)row * 128 + col + 4) = a1; } return 0.f; }
};
struct F_S5C {
    static constexpr bool PAIRED = false, NEED_RSTD = false, HAS_SSQ = false;
    typedef X8 CP; typedef U8 RP;
    const bf16_t* A2p; const float* dsk; bf16_t* YBp;
    __device__ __forceinline__ CP cpre(int row0, int col) const { const int ch = (row0 >> 10) * 16 + (col & 15); return CP{*(const f32x4*)(dsk + ch), *(const f32x4*)(dsk + ch + 4)}; }
    __device__ __forceinline__ RP rpre(int row, int col) const { return RP{*(const u32x4*)(A2p + (size_t)row * 384 + col)}; }
    __device__ __forceinline__ float fin(int row, int col, f32x4 a0, f32x4 a1, f32x4, f32x4, float, const CP& cp, const RP& r) const {
        const int g = row >> 10, b = (row >> 7) & 7, j = row & 127, s = col >> 4, c = col & 15, tok = b * LSEQ + j * 16 + s, ch = g * 16 + c;
        UNPK8(r.w, u0, u1); f32x4 o0, o1;
#pragma unroll
        for (int e = 0; e < 4; ++e) { o0[e] = gelu_tanh(a0[e] + cp.x0[e] * u0[e]); o1[e] = gelu_tanh(a1[e] + cp.x1[e] * u1[e]); }
        *(u32x4*)(YBp + (size_t)tok * D + ch) = pk8(o0, o1); return 0.f;
    }
};


template <int CTRL> __device__ __forceinline__ float dpp_mov(float x) { return __builtin_bit_cast(float, __builtin_amdgcn_mov_dpp(__builtin_bit_cast(int, x), CTRL, 0xf, 0xf, true)); }
template <int CTRL> __device__ __forceinline__ float dpp_shr_old(float old, float x) { return __builtin_bit_cast(float, __builtin_amdgcn_update_dpp(__builtin_bit_cast(int, old), __builtin_bit_cast(int, x), CTRL, 0xf, 0xf, false)); }
struct EpiFFN {
    static constexpr bool IDEMP = false;
    bf16_t* ACT; float* HALO; float* GFIX; float* UPFIX; const float* ssq_in; const float* cw; const float* cb; float* fcp; LAS float* xch;
    __device__ __forceinline__ void operator()(f32x4 (&acc)[2][2][4][2], const pg8::Unit& u, int wr, int wc, int fr, int fq) const {
        const int colg = u.pn * 128 + wc * 32 + fq * 8, pm = u.pm;
        const int tix = ((wr * 4 + wc) * 4 + fq) * 16 + fr, twhich = tix >> 7, tcol = tix & 127, rrow = tix >> 1, rh = tix & 1;
        const float* sp = ssq_in + (size_t)(pm * 256 + rrow) * 32 + rh * 16;
        const f32x4 s0 = *(const f32x4*)sp, s1 = *(const f32x4*)(sp + 4), s2 = *(const f32x4*)(sp + 8), s3 = *(const f32x4*)(sp + 12);
        const float tval = twhich < 3 ? cw[(size_t)twhich * FF + u.pn * 128 + tcol] : cb[u.pn * 128 + tcol];
        LAS float* wtab = xch + 1024; LAS float* rtab = xch + 1536;
        { const f32x4 t = (s0 + s1) + (s2 + s3); float sm = (t[0] + t[1]) + (t[2] + t[3]); sm += __shfl_xor(sm, 1); if (rh == 0) rtab[rrow] = rstd_from(sm); }
        wtab[tix] = tval;
        asm volatile("s_waitcnt lgkmcnt(0)" ::: "memory"); __builtin_amdgcn_s_barrier(); asm volatile("" ::: "memory");
#pragma unroll
        for (int ai = 0; ai < 2; ++ai)
#pragma unroll
            for (int m = 0; m < 4; ++m) { const float rs = rtab[ai * 128 + wr * 64 + m * 16 + fr];
#pragma unroll
                for (int n = 0; n < 2; ++n) { acc[ai][0][m][n] *= rs; acc[ai][1][m][n] *= rs; } }
        if (fr >= 14) {
#pragma unroll
            for (int ai = 0; ai < 2; ++ai)
#pragma unroll
                for (int n = 0; n < 2; ++n) *(LAS f32x4*)(xch + (((((ai * 2 + wr) * 4 + wc) * 2 + (fr - 14)) * 4 + fq) * 8 + n * 4)) = acc[ai][0][3][n];
            if (wr == 1) {
#pragma unroll
                for (int n = 0; n < 2; ++n) { *(f32x4*)(HALO + (size_t)(pm * 2 + fr - 14) * FF + colg + 4 * n) = acc[1][0][3][n];
                    if ((pm & 7) == 7) *(f32x4*)(fcp + (size_t)((pm >> 3) * 2 + fr - 14) * FF + colg + 4 * n) = acc[1][0][3][n]; }
            }
        }
        if (wr == 0 && fr < 2) {
#pragma unroll
            for (int n = 0; n < 2; ++n) { *(f32x4*)(GFIX + (size_t)(pm * 2 + fr) * FF + colg + 4 * n) = acc[0][0][0][n]; *(f32x4*)(UPFIX + (size_t)(pm * 2 + fr) * FF + colg + 4 * n) = acc[0][1][0][n]; }
        }
        asm volatile("s_waitcnt lgkmcnt(0)" ::: "memory"); __builtin_amdgcn_s_barrier(); asm volatile("" ::: "memory");
        f32x4 w0[2], w1[2], w2[2], bb[2];
#pragma unroll
        for (int n = 0; n < 2; ++n) { const int lc = wc * 32 + fq * 8 + 4 * n; w0[n] = *(const LAS f32x4*)(wtab + lc); w1[n] = *(const LAS f32x4*)(wtab + 128 + lc); w2[n] = *(const LAS f32x4*)(wtab + 256 + lc); bb[n] = *(const LAS f32x4*)(wtab + 384 + lc); }
#pragma unroll
        for (int ai = 0; ai < 2; ++ai) {
            f32x4 prev[2];
            if (ai == 0 && wr == 0) { prev[0] = (f32x4){0.f, 0.f, 0.f, 0.f}; prev[1] = prev[0]; }
            else { const int sbk = wr == 1 ? ai * 2 : (ai - 1) * 2 + 1;
#pragma unroll
                for (int n = 0; n < 2; ++n) prev[n] = *(const LAS f32x4*)(xch + ((((sbk * 4 + wc) * 2 + (fr & 1)) * 4 + fq) * 8 + n * 4)); }
#pragma unroll
            for (int m = 0; m < 4; ++m) {
                const int row = pm * 256 + ai * 128 + wr * 64 + m * 16 + fr; f32x4 o[2];
#pragma unroll
                for (int n = 0; n < 2; ++n) {
                    const f32x4 gc = acc[ai][0][m][n], gp = m == 0 ? prev[n] : acc[ai][0][m - 1][n], up = acc[ai][1][m][n];
#pragma unroll
                    for (int e = 0; e < 4; ++e) {
                        const float x1 = dpp_shr_old<0x111>(dpp_mov<0x121>(gp[e]), gc[e]), x2 = dpp_shr_old<0x112>(dpp_mov<0x122>(gp[e]), gc[e]);
                        const float c = bb[n][e] + x2 * w0[n][e] + x1 * w1[n][e] + gc[e] * w2[n][e];
                        o[n][e] = c * sigmoidf_(c) * up[e];
                    }
                }
                *(u32x4*)(ACT + (size_t)row * FF + colg) = pk8(o[0], o[1]);
            }
        }
    }
};
struct F_FFNIN_S {
    static constexpr bool PAIRED = true, NEED_RSTD = true, HAS_SSQ = false;
    typedef NoPre CP; typedef NoPre RP;
    bf16_t* ACT; const float* st; float* so; const float* cw; const float* cb;
    __device__ __forceinline__ CP cpre(int, int) const { return CP{}; }
    __device__ __forceinline__ RP rpre(int, int) const { return RP{}; }
    __device__ __forceinline__ float fin(int row, int col, f32x4 a0, f32x4 a1, f32x4 b0, f32x4 b1, float rs, const CP&, const RP&) const {
        const int bs = row - MP; f32x4 o[2];
#pragma unroll
        for (int n = 0; n < 2; ++n) { const int c = col + 4 * n; const f32x4 g = (n ? a1 : a0) * rs, up = (n ? b1 : b0) * rs;
            const f32x4 x0 = *(const f32x4*)(st + (size_t)(bs * 2) * FF + c), x1 = *(const f32x4*)(st + (size_t)(bs * 2 + 1) * FF + c);
            *(f32x4*)(so + (size_t)(bs * 2) * FF + c) = x1; *(f32x4*)(so + (size_t)(bs * 2 + 1) * FF + c) = g;
            const f32x4 cv = *(const f32x4*)(cb + c) + x0 * *(const f32x4*)(cw + c) + x1 * *(const f32x4*)(cw + FF + c) + g * *(const f32x4*)(cw + 2 * FF + c);
#pragma unroll
            for (int e = 0; e < 4; ++e) o[n][e] = cv[e] * sigmoidf_(cv[e]) * up[e]; }
        *(u32x4*)(ACT + (size_t)row * FF + col) = pk8(o[0], o[1]); return 0.f;
    }
};

struct F_NULL1 { static constexpr bool PAIRED = false, NEED_RSTD = false, HAS_SSQ = false; typedef NoPre CP; typedef NoPre RP; float* sink;
    __device__ __forceinline__ CP cpre(int, int) const { return CP{}; }
    __device__ __forceinline__ RP rpre(int, int) const { return RP{}; }
    __device__ __forceinline__ float fin(int row, int col, f32x4 v0, f32x4 v1, f32x4, f32x4, float, const CP&, const RP&) const { if (v0[0] == 12345.678f) sink[0] = v0[1] + v0[2] + v0[3] + v1[0]; return 0.f; } };
struct F_NULL2 { static constexpr bool PAIRED = true, NEED_RSTD = false, HAS_SSQ = false; typedef NoPre CP; typedef NoPre RP; float* sink;
    __device__ __forceinline__ CP cpre(int, int) const { return CP{}; }
    __device__ __forceinline__ RP rpre(int, int) const { return RP{}; }
    __device__ __forceinline__ float fin(int row, int col, f32x4 v0, f32x4 v1, f32x4 w0, f32x4 w1, float, const CP&, const RP&) const { if (v0[0] == 12345.678f) sink[0] = v0[1] + v1[2] + w0[3] + w1[0]; return 0.f; } };
template <class F>
__device__ __forceinline__ void sample_gemm_(LAS unsigned char* lds, const bf16_t* A, int lda, const bf16_t* Bt, int ldb, int ncb, int K, int row_base,
                                            const F& f, const float* ssq_in, float* ssq_out, int a_cb_div, int a_cb_stride, int wg0) {
    const int tid = otid(), wid = tid >> 6, lane = tid & 63, r32 = lane & 31, kq = lane >> 5;
    LAS float* red = (LAS float*)lds;
    const int ks = K / 16, k0 = wid * ks / 8, k1 = (wid + 1) * ks / 8;
    const int nwg_ = (int)gridDim.x - wg0;
    for (int tile = obid() - wg0; tile >= 0 && tile < 4 * ncb; tile += nwg_) {
        const int rb = tile & 3, cb = tile >> 2;
        const int brow0 = F::PAIRED ? ((cb >> 2) * 256 + (cb & 3) * 32) : cb * 32;
        const bf16_t* ap = A + (size_t)(rb * 32 + r32) * lda + kq * 8 + (cb / a_cb_div) * a_cb_stride;
        const bf16_t* bp = Bt + (size_t)(brow0 + r32) * ldb + kq * 8;
        f32x16 acc0, acc1;
#pragma unroll
        for (int i = 0; i < 16; ++i) { acc0[i] = 0.f; acc1[i] = 0.f; }
        constexpr int NBT = F::PAIRED ? 8 : 11;
        for (int k = k0; k < k1; k += NBT) {
            bf16x8 av[NBT], bv[NBT], cv[NBT];
#pragma unroll
            for (int i = 0; i < NBT; ++i) if (k + i < k1) { av[i] = *(const bf16x8*)(ap + (k + i) * 16); bv[i] = *(const bf16x8*)(bp + (k + i) * 16); if (F::PAIRED) cv[i] = *(const bf16x8*)(bp + (size_t)128 * ldb + (k + i) * 16); }
#pragma unroll
            for (int i = 0; i < NBT; ++i) if (k + i < k1) { acc0 = __builtin_amdgcn_mfma_f32_32x32x16_bf16(av[i], bv[i], acc0, 0, 0, 0); if (F::PAIRED) acc1 = __builtin_amdgcn_mfma_f32_32x32x16_bf16(av[i], cv[i], acc1, 0, 0, 0); }
        }
#pragma unroll
        for (int r = 0; r < 16; ++r) { const int rw = (r & 3) + 8 * (r >> 2) + 4 * kq;
            red[(wid * 32 + rw) * 33 + r32] = acc0[r]; if (F::PAIRED) red[8448 + (wid * 32 + rw) * 33 + r32] = acc1[r]; }
        __syncthreads();
        if (tid < 128) {
            const int row = tid >> 2, c8 = (tid & 3) * 8, grow = row_base + rb * 32 + row;
            f32x4 v0 = {0.f, 0.f, 0.f, 0.f}, v1 = v0, w0 = v0, w1 = v0;
#pragma unroll
            for (int w = 0; w < 8; ++w)
#pragma unroll
                for (int e = 0; e < 4; ++e) { v0[e] += red[(w * 32 + row) * 33 + c8 + e]; v1[e] += red[(w * 32 + row) * 33 + c8 + 4 + e];
                    if (F::PAIRED) { w0[e] += red[8448 + (w * 32 + row) * 33 + c8 + e]; w1[e] += red[8448 + (w * 32 + row) * 33 + c8 + 4 + e]; } }
            float rs = 1.f;
            if (F::NEED_RSTD) { const f32x4 a = *(const f32x4*)(ssq_in + (size_t)grow * 32 + (tid & 3) * 8), b = *(const f32x4*)(ssq_in + (size_t)grow * 32 + (tid & 3) * 8 + 4);
                float s = (a[0] + a[1]) + (a[2] + a[3]) + (b[0] + b[1]) + (b[2] + b[3]); s += __shfl_xor(s, 1); s += __shfl_xor(s, 2); rs = rstd_from(s); }
            const typename F::CP cp_ = f.cpre(grow, cb * 32 + c8); const typename F::RP rp_ = f.rpre(grow, cb * 32 + c8);
            float q = f.fin(grow, cb * 32 + c8, v0, v1, w0, w1, rs, cp_, rp_);
            if (F::HAS_SSQ) { q += __shfl_xor(q, 1); q += __shfl_xor(q, 2); if ((tid & 3) == 0) ssq_out[(size_t)grow * 32 + cb] = q; }
        }
        __syncthreads();
    }
}

template <class F>
__device__ __forceinline__ void sample_gemm(LAS unsigned char* lds, const bf16_t* A, int lda, const bf16_t* Bt, int ldb, int ncb, int K, int row_base,
                                            const F& f, const float* ssq_in, float* ssq_out, int a_cb_div = 1 << 30, int a_cb_stride = 0, int wg0 = 0) {
    if (wg0 >= (int)gridDim.x) wg0 = 0;
    if (PROBE_SG2) { if (F::PAIRED) { F_NULL2 n{ssq_out ? ssq_out : (float*)ssq_in}; sample_gemm_(lds, A, lda, Bt, ldb, ncb, K, row_base, n, nullptr, nullptr, a_cb_div, a_cb_stride, wg0); }
                     else { F_NULL1 n{ssq_out ? ssq_out : (float*)ssq_in}; sample_gemm_(lds, A, lda, Bt, ldb, ncb, K, row_base, n, nullptr, nullptr, a_cb_div, a_cb_stride, wg0); } }
    sample_gemm_(lds, A, lda, Bt, ldb, ncb, K, row_base, f, ssq_in, ssq_out, a_cb_div, a_cb_stride, wg0);
}
struct Args { const float* in[50]; float* out; unsigned char* ws; int lo, hi; };
enum { I_XP = 0, I_XS, I_S5RE, I_S5IM, I_WKV, I_SHIFT, I_LH, I_LC, I_FC, I_NMIX, I_NFFN, I_NFIN, I_S5ARE, I_S5AIM, I_S5LDT, I_S5BRE, I_S5BIM, I_S5CRE, I_S5CIM,
       I_S5D, I_S5GLU, I_RWMU, I_RWRKV, I_RWW0, I_RWW1, I_RWW2, I_RWA0, I_RWA1, I_RWA2, I_RWG1, I_RWG2, I_RWKK, I_RWKA, I_RWRK, I_RWLNW, I_RWLNB, I_RWWO,
       I_LWIN, I_LCW, I_LCB, I_LWRG, I_LBRG, I_LWIG, I_LBIG, I_LLAM, I_LWOUT, I_FWIN, I_FCW, I_FCB, I_FWOUT };
typedef const __attribute__((address_space(4))) Args& ArgsR;
typedef const __attribute__((address_space(4))) Args* ArgsP;
__device__ __forceinline__ ArgsP opaque_args() { ArgsP p = (ArgsP)__builtin_amdgcn_kernarg_segment_ptr(); asm volatile("" : "+s"(p)); return p; }
#define WSB(off) ((bf16_t*)(a.ws + (off)))
#define WSF(off) ((float*)(a.ws + (off)))
#define NTHR 512

__device__ __forceinline__ void tr_item(const float* W, int ldw, const float* ks, bf16_t* dst, int dst_ld, int k0, int n0, int drow0, int dk0, LAS float* scr, int lane) {
    float v[32];
    const float* wp = W + (size_t)(k0 + (lane >> 5)) * ldw + n0 + (lane & 31);
#pragma unroll
    for (int i = 0; i < 32; ++i) v[i] = wp[(size_t)(2 * i) * ldw];
    if (ks) {
#pragma unroll
        for (int i = 0; i < 32; ++i) v[i] *= ks[k0 + 2 * i + (lane >> 5)];
    }
#pragma unroll
    for (int i = 0; i < 32; ++i) scr[(2 * i + (lane >> 5)) * 33 + (lane & 31)] = v[i];
    asm volatile("s_waitcnt lgkmcnt(0)" ::: "memory");
    const int c = lane & 7;
#pragma unroll
    for (int j = 0; j < 4; ++j) { const int n = (lane >> 3) + 8 * j; const LAS float* s = scr + (8 * c) * 33 + n;
        u32x4 o; o.x = pk2(s[0 * 33], s[1 * 33]); o.y = pk2(s[2 * 33], s[3 * 33]); o.z = pk2(s[4 * 33], s[5 * 33]); o.w = pk2(s[6 * 33], s[7 * 33]);
        *(u32x4*)(dst + (size_t)(drow0 + n) * dst_ld + dk0 + k0 + 8 * c) = o; }
    asm volatile("s_waitcnt lgkmcnt(0)" ::: "memory");
}

__device__ __forceinline__ void convert_items(ArgsR a, LAS unsigned char* lds, int gw, int NGW, int which) {
    const int tid = otid(), lane = tid & 63, wave = tid >> 6;
    LAS float* scr = (LAS float*)(lds + wave * 16384);
    const int total = which == 0 ? 13312 : 11264;
#pragma nounroll
    for (int q = gw; q < total; q += NGW) {
        int fit;
        if (which == 0) fit = q < 1024 ? q : (q < 6656 ? 2048 + (q - 1024) : (q < 9472 ? 13312 + (q - 6656) : 18944 + (q - 9472)));
        else fit = q < 1024 ? 1024 + q : (q < 6656 ? 7680 + (q - 1024) : (q < 9472 ? 16128 + (q - 6656) : 22784 + (q - 9472)));
        int job, it;
        if (fit < 2048) { job = fit >> 10; it = fit & 1023; }
        else if (fit < 13312) { const int q = fit - 2048; job = 2 + q / 2816; it = q % 2816; }
        else if (fit < 18944) { const int q = fit - 13312; job = 6 + q / 1408; it = q % 1408; }
        else if (fit < 22016) { const int q = fit - 18944; job = 10 + (q >> 9); it = q & 511; }
        else if (fit < 22272) { const int q = fit - 22016; if (q < 128) { job = 16 + (q >> 5); it = q & 31; } else { job = 20 + ((q - 128) >> 6); it = (q - 128) & 63; } }
        else if (fit < 22784) { job = 22; it = fit - 22272; }
        else if (fit < 23808) { job = 23; it = fit - 22784; }
        else if (fit < 24064) { const int q = fit - 23808; job = 24 + (q >> 5); it = q & 31; }
        else { job = 32; it = fit - 24064; }
        const float* src; const float* ks = nullptr; bf16_t* dst; int ldw, K, N, dst_ld, dk0 = 0, H = 0, row_off = 0;
        if (job < 2) { src = a.in[I_S5GLU] + (size_t)job * 1024 * 2048; ldw = 2048; K = 1024; N = 2048; dst = WSB(WS_WGLU) + (size_t)job * 2048 * 1024; dst_ld = 1024; H = 1024; }
        else if (job < 6) { const int i = job - 2; src = a.in[I_FWIN] + (size_t)i * 1024 * 5632; ldw = 5632; K = 1024; N = 5632; ks = a.in[I_NFFN] + i * 1024; dst = WSB(WS_WFIN) + (size_t)i * 5632 * 1024; dst_ld = 1024; H = 2816; }
        else if (job < 10) { const int i = job - 6; src = a.in[I_FWOUT] + (size_t)i * 2816 * 1024; ldw = 1024; K = 2816; N = 1024; dst = WSB(WS_WFOUT) + (size_t)i * 1024 * 2816; dst_ld = 2816; }
        else if (job < 16) { const int q = job - 10, j = q >> 1, hf = q & 1; src = a.in[I_RWRKV] + (size_t)j * 1024 * 1024; ldw = 1024; K = 1024; N = 1024; if (hf) ks = a.in[I_RWMU] + j * 1024;
            dst = WSB(WS_WRW2); dst_ld = 2048; dk0 = hf * 1024; row_off = j * 1024; }
        else if (job < 22) { const int q = job - 16, m = q >> 1, hf = q & 1; src = m == 0 ? a.in[I_RWW1] : (m == 1 ? a.in[I_RWA1] : a.in[I_RWG1]); N = m == 2 ? 128 : 64; ldw = N; K = 1024;
            if (hf) ks = a.in[I_RWMU] + (3 + m) * 1024; dst = WSB(WS_WRW2); dst_ld = 2048; dk0 = hf * 1024; row_off = 3072 + m * 64; }
        else if (job == 22) { src = a.in[I_RWWO]; ldw = 1024; K = 1024; N = 1024; dst = WSB(WS_WRWO); dst_ld = 1024; }
        else if (job == 23) { src = a.in[I_LWIN]; ldw = 2048; K = 1024; N = 2048; ks = a.in[I_NMIX] + 2 * 1024; dst = WSB(WS_WLIN); dst_ld = 1024; H = 1024; }
        else if (job < 32) { const int q = job - 24, kind = q >> 2, nb = q & 3; src = (kind ? a.in[I_LWIG] : a.in[I_LWRG]) + (size_t)nb * 65536; ldw = 256; K = 256; N = 256;
            dst = WSB(WS_WRGIG); dst_ld = 256; H = 256; row_off = nb * 512 + kind * 128; }
        else { src = a.in[I_LWOUT]; ldw = 1024; K = 1024; N = 1024; dst = WSB(WS_WLOUT); dst_ld = 1024; }
        (void)K;
        const int nblk = N / 32;
        {
            const int kb = it / nblk, nbk = it % nblk, n0 = nbk * 32;
            int drow0;
            if (H) { const int nr = n0 % H, kind = n0 / H; drow0 = row_off + (nr >> 7) * 256 + kind * 128 + (nr & 127); } else drow0 = row_off + n0;
            tr_item(src, ldw, ks, dst, dst_ld, kb * 64, n0, drow0, dk0, scr, lane);
        }
    }
}
__device__ __forceinline__ void prologue_weights(ArgsR a, LAS unsigned char* lds) {
    const int tid = otid(), lane = tid & 63, wave = tid >> 6;
    const int gw = obid() * 8 + wave, NGW = gridDim.x * 8;
    convert_items(a, lds, gw, NGW, 0);
    const int gt = obid() * NTHR + tid, NGT = gridDim.x * NTHR;
    for (int it = gt; it < 3072 * 32; it += NGT) {
        const int n = it >> 5, k8 = (it & 31) * 8, j = n >> 10, c = n & 1023; float v[8];
#pragma unroll
        for (int e = 0; e < 8; ++e) { const int k = k8 + e; float x = 0.f;
            if (j == 0) { if (k < 64) x = a.in[I_RWW2][(size_t)k * 1024 + c]; }
            else if (j == 1) { if (k >= 64 && k < 128) x = a.in[I_RWA2][(size_t)(k - 64) * 1024 + c]; }
            else { if (k >= 128) x = a.in[I_RWG2][(size_t)(k - 128) * 1024 + c]; }
            v[e] = x; }
        u32x4 o; o.x = pk2(v[0], v[1]); o.y = pk2(v[2], v[3]); o.z = pk2(v[4], v[5]); o.w = pk2(v[6], v[7]);
        *(u32x4*)(WSB(WS_WRW3) + (size_t)n * 256 + k8) = o;
    }
    for (int c = gt; c < 1024; c += NGT) { const float lam = a.in[I_LLAM][c]; WSF(WS_LSL)[c] = -8.f * log1pf(__expf(-lam)); }
    for (int row0 = gw; row0 < MA; row0 += 4 * NGW) {
        f32x4 xv[4][4]; int rws[4];
#pragma unroll
        for (int u = 0; u < 4; ++u) { const int row = row0 + u * NGW < MA ? row0 + u * NGW : row0; rws[u] = row;
            const float* xr = row < MP ? a.in[I_XP] + (size_t)row * D : a.in[I_XS] + (size_t)(row - MP) * D;
#pragma unroll
            for (int q = 0; q < 4; ++q) xv[u][q] = *(const f32x4*)(xr + lane * 4 + 256 * q); }
        float sv[4];
#pragma unroll
        for (int u = 0; u < 4; ++u) { float t = 0.f;
#pragma unroll
            for (int q = 0; q < 4; ++q) { const f32x4 v = xv[u][q]; t += (v[0] * v[0] + v[1] * v[1]) + (v[2] * v[2] + v[3] * v[3]); }
            sv[u] = t; }
#pragma unroll
        for (int o = 1; o < 64; o <<= 1) {
#pragma unroll
            for (int u = 0; u < 4; ++u) sv[u] += __shfl_xor(sv[u], o); }
#pragma unroll
        for (int u = 0; u < 4; ++u) if (lane < 32 && (u == 0 || row0 + u * NGW < MA)) WSF(WS_SSQ)[(size_t)rws[u] * 32 + lane] = lane == 0 ? sv[u] : 0.f;
    }
}

__device__ const double s5_kc[12] = {1.0 / 24, 1.0 / 720, 1.0 / 40320, 1.0 / 3628800, 1.0 / 479001600, 1.0 / 6, 1.0 / 120, 1.0 / 5040, 1.0 / 362880, 1.0 / 39916800, 1.0 / 6227020800.0, 0.0};
__device__ __forceinline__ void s5_gen(ArgsR a, LAS unsigned char* lds, int j) {
    const int tid = otid();
    LAS float* abp = (LAS float*)lds;
    LAS float* cB = abp + 17 * 128;
    LAS float* Cc = cB + 2048;
    LAS float* Kt = Cc + 2048;
    for (int g4 = obid(); g4 < 256; g4 += gridDim.x) {
        const int g = g4 >> 2, part = g4 & 3;
        __syncthreads();
        if (tid < 64) {
            const int p = tid, idx = (j * 64 + g) * 64 + p;
            const double lr = (double)fminf(a.in[I_S5ARE][idx], -1e-4f), li = (double)a.in[I_S5AIM][idx], dt = exp((double)a.in[I_S5LDT][j * 64 + g]);
            const double mag = exp(lr * dt); double ang = li * dt * 0.15915494309189535; ang -= rint(ang); const double th = ang * 6.283185307179586 * 0.125;
            const double t2 = th * th;
            const double* kc = s5_kc; asm volatile("" : "+s"(kc));
            double cs = 1.0 - t2 * (0.5 - t2 * (kc[0] - t2 * (kc[1] - t2 * (kc[2] - t2 * (kc[3] - t2 * kc[4])))));
            double sn = th * (1.0 - t2 * (kc[5] - t2 * (kc[6] - t2 * (kc[7] - t2 * (kc[8] - t2 * (kc[9] - t2 * kc[10]))))));
#pragma unroll
            for (int r = 0; r < 3; ++r) { const double c2 = cs * cs - sn * sn, s2 = 2.0 * cs * sn; cs = c2; sn = s2; }
            const double abr = mag * cs, abi = mag * sn, den = lr * lr + li * li;
            const double cr = ((abr - 1.0) * lr + abi * li) / den, ci = (abi * lr - (abr - 1.0) * li) / den;
            double pr = 1.0, pi = 0.0;
#pragma unroll 1
            for (int t = 0; t <= 16; ++t) { abp[(t * 64 + p) * 2] = (float)pr; abp[(t * 64 + p) * 2 + 1] = (float)pi; const double nr = pr * abr - pi * abi, ni = pr * abi + pi * abr; if (t < 16) { pr = nr; pi = ni; } }
            float* tb = WSF(WS_TBL) + (size_t)idx * 8;
            if (part == 0) { tb[0] = (float)abr; tb[1] = (float)abi; tb[2] = (float)cr; tb[3] = (float)ci; tb[4] = (float)pr; tb[5] = (float)pi; tb[6] = 0.f; tb[7] = 0.f; }
            const float crf = (float)cr, cif = (float)ci;
#pragma unroll 4
            for (int c = 0; c < 16; ++c) { const float br = a.in[I_S5BRE][(size_t)idx * 16 + c], bi = a.in[I_S5BIM][(size_t)idx * 16 + c];
                cB[(p * 16 + c) * 2] = crf * br - cif * bi; cB[(p * 16 + c) * 2 + 1] = crf * bi + cif * br; }
        }
        for (int e = tid; e < 1024; e += NTHR) { const size_t si = (size_t)(j * 64 + g) * 1024 + e; Cc[e * 2] = a.in[I_S5CRE][si]; Cc[e * 2 + 1] = a.in[I_S5CIM][si]; }
        __syncthreads();
        if (tid < 256) {
            const int tau = tid >> 4, c1 = tid & 15; float acc[16];
#pragma unroll
            for (int c = 0; c < 16; ++c) acc[c] = 0.f;
#pragma unroll 2
            for (int p = 0; p < 64; ++p) {
                const float ar = abp[(tau * 64 + p) * 2], ai = abp[(tau * 64 + p) * 2 + 1], br = cB[(p * 16 + c1) * 2], bi = cB[(p * 16 + c1) * 2 + 1];
                const float wr = ar * br - ai * bi, wi = ar * bi + ai * br;
#pragma unroll
                for (int c = 0; c < 16; ++c) acc[c] += Cc[(c * 64 + p) * 2] * wr - Cc[(c * 64 + p) * 2 + 1] * wi;
            }
#pragma unroll
            for (int c = 0; c < 16; ++c) Kt[(tau * 16 + c) * 16 + c1] = acc[c];
        }
        __syncthreads();
        bf16_t* BC = WSB(WS_AR + AR_S5C) + (size_t)g * 256 * 384;
        for (int e = part * 64 * 192 + tid; e < (part + 1) * 64 * 192; e += NTHR) {
            const int n = e / 192, k2 = (e % 192) * 2, s = n >> 4, c = n & 15; float v[2];
#pragma unroll
            for (int hh = 0; hh < 2; ++hh) { const int k = k2 + hh;
                if (k < 256) { const int s1 = k >> 4, c1 = k & 15; v[hh] = s >= s1 ? Kt[((s - s1) * 16 + c) * 16 + c1] : 0.f; }
                else { const int p = (k - 256) >> 1, part = (k - 256) & 1; const float cr = Cc[(c * 64 + p) * 2], ci = Cc[(c * 64 + p) * 2 + 1], ar = abp[((s + 1) * 64 + p) * 2], ai = abp[((s + 1) * 64 + p) * 2 + 1];
                    v[hh] = part == 0 ? (cr * ar - ci * ai) : -(cr * ai + ci * ar); } }
            *(unsigned*)(BC + (size_t)n * 384 + k2) = pk2(v[0], v[1]);
        }
        bf16_t* BA = WSB(WS_AR + AR_S5A) + (size_t)g * 256 * 256;
        for (int e = part * 64 * 128 + tid; e < (part + 1) * 64 * 128; e += NTHR) {
            const int n = e >> 7, k2 = (e & 127) * 2; float v[2] = {0.f, 0.f};
            if (n < 128) { const int p = n >> 1, part = n & 1;
#pragma unroll
                for (int hh = 0; hh < 2; ++hh) { const int k = k2 + hh, s1 = k >> 4, c1 = k & 15; const float ar = abp[((15 - s1) * 64 + p) * 2], ai = abp[((15 - s1) * 64 + p) * 2 + 1], br = cB[(p * 16 + c1) * 2], bi = cB[(p * 16 + c1) * 2 + 1];
                    v[hh] = part == 0 ? (ar * br - ai * bi) : (ar * bi + ai * br); } }
            *(unsigned*)(BA + (size_t)n * 256 + k2) = pk2(v[0], v[1]);
        }
    }
    __syncthreads();
}

__device__ __forceinline__ void s5_u_phase(ArgsR a, int li, int j) {
    const int tid = otid(), lane = tid & 63, wave = tid >> 6, gw = obid() * 8 + wave, NGW = gridDim.x * 8;
    const float* X = li == 0 ? a.in[I_XP] : a.out; const float* SSQ = WSF(WS_SSQ); const float* gm = a.in[I_NMIX] + li * 1024; bf16_t* A2 = WSB(WS_AR + AR_A2);
    for (int it = gw; it < 4096; it += NGW) {
        const int qd = it & 3, jj = (it >> 2) & 127, b = it >> 9, t0 = b * LSEQ + jj * 16;
        float rs = 0.f;
        { const int s = lane & 15; const float* sp = SSQ + (size_t)(t0 + s) * 32; float q = 0.f;
#pragma unroll
          for (int e = 0; e < 8; ++e) { const f32x4 v = *(const f32x4*)(sp + e * 4); q += (v[0] + v[1]) + (v[2] + v[3]); }
          rs = rstd_from(q); }
        const int s = (lane >> 1) & 15, hf = lane & 1; const float rss = __shfl(rs, s);
        f32x4 xa[8], xb[8];
#pragma unroll
        for (int i = 0; i < 8; ++i) { const int g = (qd * 8 + i) * 2 + (lane >> 5), ch0 = g * 16 + hf * 8; xa[i] = *(const f32x4*)(X + (size_t)(t0 + s) * D + ch0); xb[i] = *(const f32x4*)(X + (size_t)(t0 + s) * D + ch0 + 4); }
#pragma unroll
        for (int i = 0; i < 8; ++i) {
            const int g = (qd * 8 + i) * 2 + (lane >> 5), ch0 = g * 16 + hf * 8;
            const f32x4 g0 = *(const f32x4*)(gm + ch0), g1 = *(const f32x4*)(gm + ch0 + 4);
            const f32x4 u0 = xa[i] * g0 * rss, u1 = xb[i] * g1 * rss; const u32x2 p0 = pk4(u0), p1 = pk4(u1);
            *(u32x4*)(A2 + (size_t)(g * 1024 + b * 128 + jj) * 384 + s * 16 + hf * 8) = (u32x4){p0.x, p0.y, p1.x, p1.y};
        }
    }
    const float* TBL = WSF(WS_TBL); bf16_t* YB = WSB(WS_AR + AR_YB);
    for (int it = gw; it < 128 * 64; it += NGW) {
        const int g = it & 63, bs = it >> 6, row = MP + bs, p = lane;
        float q = lane < 32 ? SSQ[(size_t)row * 32 + lane] : 0.f; q = wave_sum(q); const float rs = rstd_from(q);
        const int cc = lane & 15; const float* xsr = li == 0 ? a.in[I_XS] + (size_t)bs * D : a.out + (size_t)row * D; const float uc = xsr[g * 16 + cc] * rs * gm[g * 16 + cc];
        const size_t pi = (size_t)((j * 64 + g) * 64 + p);
        float bur = 0.f, bui = 0.f;
#pragma unroll
        for (int c = 0; c < 16; ++c) { const float u = __shfl(uc, c); bur += a.in[I_S5BRE][pi * 16 + c] * u; bui += a.in[I_S5BIM][pi * 16 + c] * u; }
        const float* tb = TBL + pi * 8; const float abr = tb[0], abi = tb[1], cr = tb[2], ci = tb[3];
        const size_t si = (size_t)(j * 128 + bs) * 4096 + g * 64 + p;
        const float h0r = a.in[I_S5RE][si], h0i = a.in[I_S5IM][si];
        const float hr = abr * h0r - abi * h0i + (cr * bur - ci * bui), hi = abr * h0i + abi * h0r + (cr * bui + ci * bur);
        a.out[O_S5RE_S + si] = hr; a.out[O_S5IM_S + si] = hi;
        float yv = 0.f; float tsum[16];
#pragma unroll
        for (int c = 0; c < 16; ++c) { const size_t ci2 = (size_t)((j * 64 + g) * 16 + c) * 64 + p; tsum[c] = a.in[I_S5CRE][ci2] * hr - a.in[I_S5CIM][ci2] * hi; }
#pragma unroll
        for (int o = 1; o < 64; o <<= 1) {
#pragma unroll
            for (int c = 0; c < 16; ++c) tsum[c] += __shfl_xor(tsum[c], o); }
#pragma unroll
        for (int c = 0; c < 16; ++c) if (cc == c) yv = tsum[c];
        if (lane < 16) { const float y = yv + a.in[I_S5D][j * 1024 + g * 16 + cc] * uc; YB[(size_t)row * D + g * 16 + cc] = (bf16_t)f2bf(gelu_tanh(y)); }
    }
}
__device__ __forceinline__ void s5_carry_phase(ArgsR a, int j) {
    const int gt = obid() * NTHR + otid(), NGT = gridDim.x * NTHR, lane = otid() & 63, lb = lane & ~3;
    const float* TBL = WSF(WS_TBL); const float* HL = WSF(WS_AR + AR_HLOC); bf16_t* A2 = WSB(WS_AR + AR_A2);
    for (int id = gt; id < 131072; id += NGT) {
        const int sg = id & 3, p = (id >> 2) & 63, g = (id >> 8) & 63, b = id >> 14; const float* tb = TBL + (size_t)((j * 64 + g) * 64 + p) * 8; const float ar = tb[4], ai = tb[5];
        const size_t row0 = (size_t)g * 1024 + b * 128 + sg * 32;
        float er = 0.f, ei = 0.f;
#pragma unroll 16
        for (int k = 0; k < 32; ++k) { const f32x2 hl = *(const f32x2*)(HL + (row0 + k) * 128 + 2 * p); const float nr = ar * er - ai * ei + hl.x, ni = ar * ei + ai * er + hl.y; er = nr; ei = ni; }
        float pr = ar, pi = ai;
#pragma unroll
        for (int q = 0; q < 5; ++q) { const float nr = pr * pr - pi * pi, ni = 2.f * pr * pi; pr = nr; pi = ni; }
        const float e0r = __shfl(er, lb), e0i = __shfl(ei, lb), e1r = __shfl(er, lb + 1), e1i = __shfl(ei, lb + 1), e2r = __shfl(er, lb + 2), e2i = __shfl(ei, lb + 2);
        const float h1r = e0r, h1i = e0i;
        const float h2r = pr * h1r - pi * h1i + e1r, h2i = pr * h1i + pi * h1r + e1i;
        const float h3r = pr * h2r - pi * h2i + e2r, h3i = pr * h2i + pi * h2r + e2i;
        float hr = sg == 0 ? 0.f : (sg == 1 ? h1r : (sg == 2 ? h2r : h3r)), hi = sg == 0 ? 0.f : (sg == 1 ? h1i : (sg == 2 ? h2i : h3i));
#pragma unroll 1
        for (int k0 = 0; k0 < 32; k0 += 16) { f32x2 hl[16];
#pragma unroll
            for (int k = 0; k < 16; ++k) hl[k] = *(const f32x2*)(HL + (row0 + k0 + k) * 128 + 2 * p);
#pragma unroll
            for (int k = 0; k < 16; ++k) { *(unsigned*)(A2 + (row0 + k0 + k) * 384 + 256 + 2 * p) = pk2(hr, hi);
                const float nr = ar * hr - ai * hi + hl[k].x, ni = ar * hi + ai * hr + hl[k].y; hr = nr; hi = ni; } }
        if (sg == 3) { const size_t so = (size_t)(j * 8 + b) * 4096 + g * 64 + p; a.out[O_S5RE_P + so] = hr; a.out[O_S5IM_P + so] = hi; }
    }
}

__device__ __forceinline__ void unpk8(u32x4 w, float* x) { x[0] = bflo(w.x); x[1] = bfhi(w.x); x[2] = bflo(w.y); x[3] = bfhi(w.y); x[4] = bflo(w.z); x[5] = bfhi(w.z); x[6] = bflo(w.w); x[7] = bfhi(w.w); }
__device__ __forceinline__ void ffn_conv_phase(ArgsR a, int li, bool st = true) {
    const int gt = obid() * NTHR + otid(), NGT = gridDim.x * NTHR;
    const bf16_t* G = WSB(WS_AR + AR_G); bf16_t* UP = WSB(WS_AR + AR_UP);
    const float* cw = a.in[I_FCW] + (size_t)li * 3 * FF; const float* cb = a.in[I_FCB] + (size_t)li * FF;
    for (int it = gt; it < (MP / 4) * (FF / 8); it += NGT) {
        const int rq = it / (FF / 8), f = (it % (FF / 8)) * 8, row0 = rq * 4, l0 = row0 & (LSEQ - 1);
        u32x4 g[6], uw[4];
        const u32x4 z = {0, 0, 0, 0};
        g[0] = l0 ? *(const u32x4*)(G + (size_t)(row0 - 2) * FF + f) : z; g[1] = l0 ? *(const u32x4*)(G + (size_t)(row0 - 1) * FF + f) : z;
#pragma unroll
        for (int r = 0; r < 4; ++r) { g[2 + r] = *(const u32x4*)(G + (size_t)(row0 + r) * FF + f); uw[r] = *(const u32x4*)(UP + (size_t)(row0 + r) * FF + f); }
        float w0[8], w1[8], w2[8], bb[8];
#pragma unroll
        for (int e = 0; e < 8; ++e) { w0[e] = cw[f + e]; w1[e] = cw[FF + f + e]; w2[e] = cw[2 * FF + f + e]; bb[e] = cb[f + e]; }
        float x[6][8];
#pragma unroll
        for (int r = 0; r < 6; ++r) unpk8(g[r], x[r]);
#pragma unroll
        for (int r = 0; r < 4; ++r) {
            float up[8], o[8]; unpk8(uw[r], up);
#pragma unroll
            for (int e = 0; e < 8; ++e) { const float c = bb[e] + x[r][e] * w0[e] + x[r + 1][e] * w1[e] + x[r + 2][e] * w2[e]; o[e] = c * sigmoidf_(c) * up[e]; }
            u32x4 ov; ov.x = pk2(o[0], o[1]); ov.y = pk2(o[2], o[3]); ov.z = pk2(o[4], o[5]); ov.w = pk2(o[6], o[7]);
            if (st) *(u32x4*)(UP + (size_t)(row0 + r) * FF + f) = ov;
        }
        if (st && l0 == LSEQ - 4) { float* o = a.out + O_FC_P + ((size_t)(li * 8 + (row0 >> 11)) * 2) * FF + f;
#pragma unroll
            for (int e = 0; e < 8; ++e) { o[e] = x[4][e]; o[FF + e] = x[5][e]; } }
    }
    if (st)
    for (int it = gt; it < MS * (FF / 8); it += NGT) {
        const int bs = it / (FF / 8), f = (it % (FF / 8)) * 8, row = MP + bs;
        float x0[8], x1[8], x2[8], up[8], r[8];
        unpk8(*(const u32x4*)(G + (size_t)row * FF + f), x2); unpk8(*(const u32x4*)(UP + (size_t)row * FF + f), up);
        const float* st = a.in[I_FC] + ((size_t)(li * 128 + bs) * 2) * FF + f; float* o = a.out + O_FC_S + ((size_t)(li * 128 + bs) * 2) * FF + f;
#pragma unroll
        for (int e = 0; e < 8; ++e) { x0[e] = st[e]; x1[e] = st[FF + e]; }
#pragma unroll
        for (int e = 0; e < 8; ++e) { o[e] = x1[e]; o[FF + e] = x2[e]; const float c = cb[f + e] + x0[e] * cw[f + e] + x1[e] * cw[FF + f + e] + x2[e] * cw[2 * FF + f + e]; r[e] = c * sigmoidf_(c) * up[e]; }
        u32x4 ov; ov.x = pk2(r[0], r[1]); ov.y = pk2(r[2], r[3]); ov.z = pk2(r[4], r[5]); ov.w = pk2(r[6], r[7]);
        *(u32x4*)(UP + (size_t)row * FF + f) = ov;
    }
}

__device__ __forceinline__ void rw1_phase(ArgsR a, int li) {
    const int tid = otid(), lane = tid & 63, wave = tid >> 6, gw = obid() * 8 + wave, NGW = gridDim.x * 8;
    const float* X = a.out; const float* SSQ = WSF(WS_SSQ); const float* gm = a.in[I_NMIX] + li * 1024; bf16_t* HX = WSB(WS_AR + AR_HX);
    for (int row = gw; row < MA; row += NGW) {
        const bool prm = row < MP; const int l = row & (LSEQ - 1); const bool hasprev = prm && l > 0;
        float q = 0.f;
        if (lane < 32) q = SSQ[(size_t)row * 32 + lane]; else if (hasprev) q = SSQ[(size_t)(row - 1) * 32 + lane - 32];
        f32x4 xv[4], pv[4], g4[4];
        const float* prow = hasprev ? X + (size_t)(row - 1) * D : (prm ? X + (size_t)row * D : a.in[I_SHIFT] + (size_t)(row - MP) * D);
#pragma unroll
        for (int qq = 0; qq < 4; ++qq) { const int c = lane * 4 + 256 * qq; xv[qq] = *(const f32x4*)(X + (size_t)row * D + c); pv[qq] = *(const f32x4*)(prow + c); g4[qq] = *(const f32x4*)(gm + c); }
#pragma unroll
        for (int o = 1; o < 32; o <<= 1) q += __shfl_xor(q, o);
        const float rs = rstd_from(__shfl(q, 0)), rsp = rstd_from(__shfl(q, 32));
#pragma unroll
        for (int qq = 0; qq < 4; ++qq) {
            const int c = lane * 4 + 256 * qq;
            const f32x4 h = xv[qq] * g4[qq] * rs; f32x4 p = pv[qq];
            if (hasprev) p = p * g4[qq] * rsp; else if (prm) p = (f32x4){0.f, 0.f, 0.f, 0.f};
            *(u32x2*)(HX + (size_t)row * 2048 + c) = pk4(h); *(u32x2*)(HX + (size_t)row * 2048 + 1024 + c) = pk4(p - h);
            if (!prm) *(f32x4*)(a.out + O_SH_S + (size_t)(row - MP) * D + c) = h;
            else if (l == LSEQ - 1) *(f32x4*)(a.out + O_SH_P + (size_t)(row >> 11) * D + c) = h;
        }
    }
}

struct RwPrep { f32x4 nk, w, ka, kp, r; float bd; };
__device__ __forceinline__ RwPrep rw_prep(u32x2 rr, u32x2 rk, u32x2 rd, u32x2 ra, f32x4 kkc, f32x4 kac, f32x4 rkc) {
    RwPrep o; const f32x4 r = unpk4(rr), k = unpk4(rk), d = unpk4(rd), aa = unpk4(ra);
    const f32x4 kk = k * kkc; float ss = (kk[0] * kk[0] + kk[1] * kk[1]) + (kk[2] * kk[2] + kk[3] * kk[3]); ss = row16_sum(ss);
    const float inv = 1.f / fmaxf(sqrtf(ss), 1e-12f); const f32x4 kkn = kk * inv;
    o.nk = -kkn; o.ka = kkn * aa; o.kp = k * (1.f + (aa - 1.f) * kac); o.w = 1.f - d; o.r = r;
    const f32x4 t = r * o.kp * rkc; float bd = (t[0] + t[1]) + (t[2] + t[3]); o.bd = row16_sum(bd);
    return o;
}
__device__ __forceinline__ void rw4_phase(ArgsR a, LAS unsigned char* lds) {
    const int tid = otid(), il = tid >> 4, jl = tid & 15, tt = tid >> 4, c4 = (tid & 15) * 4;
    const bf16_t* Rg = WSB(WS_AR + AR_RKV); const bf16_t* Kg = Rg + RKV_PLANE / 2; const bf16_t* Vg = Rg + RKV_PLANE;
    const bf16_t* DEC = WSB(WS_AR + AR_DEC); const bf16_t* AA = WSB(WS_AR + AR_AA);
    bf16_t* ORAW = WSB(WS_XB); float* BD = WSF(WS_CAR);
    LAS float* L = (LAS float*)lds; constexpr int ARR = 2048;
    LAS float* OL = L + 12 * ARR; LAS float* BON = OL + 1024;
    for (int rep = 0; rep < (PROBE_RW4 ? 2 : 1); ++rep)
    for (int item = obid(); item < 256; item += gridDim.x) {
        const bool wr_ = rep == (PROBE_RW4 ? 1 : 0);
        const int half = item & 1, h = (item >> 1) & 15, b = item >> 5, irow = half * 32 + il;
        const f32x4 kkc = *(const f32x4*)(a.in[I_RWKK] + h * 64 + c4), kac = *(const f32x4*)(a.in[I_RWKA] + h * 64 + c4), rkc = *(const f32x4*)(a.in[I_RWRK] + h * 64 + c4);
        f32x4 S = {0.f, 0.f, 0.f, 0.f};
        size_t off = (size_t)(b * LSEQ + tt) * D + h * 64 + c4;
        u32x2 rr = *(const u32x2*)(Rg + off), rk = *(const u32x2*)(Kg + off), rv = *(const u32x2*)(Vg + off), rd = *(const u32x2*)(DEC + off), ra = *(const u32x2*)(AA + off);
        __syncthreads();
#pragma unroll 1
        for (int c = 0; c < LSEQ / 32; ++c) {
            const int bi = c & 1; LAS float* B = L + bi * 6 * ARR;
            { const RwPrep pp = rw_prep(rr, rk, rd, ra, kkc, kac, rkc); const int o = tt * 64 + c4;
              *(LAS f32x4*)(B + 0 * ARR + o) = pp.nk; *(LAS f32x4*)(B + 1 * ARR + o) = pp.w; *(LAS f32x4*)(B + 2 * ARR + o) = pp.ka; *(LAS f32x4*)(B + 3 * ARR + o) = pp.kp;
              *(LAS f32x4*)(B + 4 * ARR + o) = pp.r; *(LAS f32x4*)(B + 5 * ARR + o) = unpk4(rv); if (jl == 0) BON[bi * 32 + tt] = pp.bd; }
            __syncthreads();
            const int row0 = b * LSEQ + c * 32;
            if (c + 1 < LSEQ / 32) { off += (size_t)32 * D;
                rr = *(const u32x2*)(Rg + off); rk = *(const u32x2*)(Kg + off); rv = *(const u32x2*)(Vg + off); rd = *(const u32x2*)(DEC + off); ra = *(const u32x2*)(AA + off); }
            {
                const LAS float* Bj = B + jl * 4; const LAS float* Bv = B + 5 * ARR + irow;
                f32x4 nk = *(const LAS f32x4*)(Bj), ww = *(const LAS f32x4*)(Bj + ARR), ka = *(const LAS f32x4*)(Bj + 2 * ARR), kq = *(const LAS f32x4*)(Bj + 3 * ARR), rq = *(const LAS f32x4*)(Bj + 4 * ARR);
                float vv = Bv[0];
#pragma unroll 1
                for (int t4 = 0; t4 < 32; t4 += 4) {
                    float qs[4];
#pragma unroll
                    for (int u = 0; u < 4; ++u) {
                        const int tn = (t4 + u + 1) & 31;
                        const f32x4 nk2 = *(const LAS f32x4*)(Bj + tn * 64), ww2 = *(const LAS f32x4*)(Bj + ARR + tn * 64), ka2 = *(const LAS f32x4*)(Bj + 2 * ARR + tn * 64),
                                    kq2 = *(const LAS f32x4*)(Bj + 3 * ARR + tn * 64), rq2 = *(const LAS f32x4*)(Bj + 4 * ARR + tn * 64);
                        const float vv2 = Bv[tn * 64];
                        float p0 = S[0] * nk[0]; p0 = __builtin_fmaf(S[1], nk[1], p0); p0 = __builtin_fmaf(S[2], nk[2], p0); p0 = __builtin_fmaf(S[3], nk[3], p0);
                        p0 = row16_sum(p0);
                        S = S * ww + ka * p0 + kq * vv;
                        float q0 = S[0] * rq[0]; q0 = __builtin_fmaf(S[1], rq[1], q0); q0 = __builtin_fmaf(S[2], rq[2], q0); q0 = __builtin_fmaf(S[3], rq[3], q0);
                        qs[u] = row16_sum(q0);
                        nk = nk2; ww = ww2; ka = ka2; kq = kq2; rq = rq2; vv = vv2;
                    }
                    if (jl == 0) { OL[(t4 + 0) * 32 + il] = qs[0]; OL[(t4 + 1) * 32 + il] = qs[1]; OL[(t4 + 2) * 32 + il] = qs[2]; OL[(t4 + 3) * 32 + il] = qs[3]; }
                }
            }
            __syncthreads();
            if (wr_) { const f32x2 ov = *(const LAS f32x2*)(OL + tt * 32 + jl * 2);
                *(unsigned*)(ORAW + (size_t)(row0 + tt) * D + h * 64 + half * 32 + jl * 2) = pk2(ov.x, ov.y);
                if (half == 0 && tid < 32) BD[(size_t)(row0 + tid) * 16 + h] = BON[bi * 32 + tid]; }
        }
        if (wr_) *(f32x4*)(a.out + O_WKV_P + ((size_t)(b * 16 + h) * 64 + irow) * 64 + jl * 4) = S;
        __syncthreads();
    }
}
__device__ __forceinline__ void rw4b_phase(ArgsR a, LAS unsigned char* lds) {
    const int tid = otid(), rp = tid >> 4, jl = tid & 15, i0 = 2 * rp, i1 = i0 + 1;
    bf16_t* Rg = WSB(WS_AR + AR_RKV); const bf16_t* Kg = Rg + RKV_PLANE / 2; const bf16_t* Vg = Rg + RKV_PLANE;
    const bf16_t* DEC = WSB(WS_AR + AR_DEC); const bf16_t* AA = WSB(WS_AR + AR_AA); const bf16_t* GG = WSB(WS_AR + AR_GG);
    const bf16_t* ORAW = WSB(WS_XB); const float* BD = WSF(WS_CAR);
    LAS float* OL = (LAS float*)lds;
    {
        const int gt = obid() * NTHR + tid, NGT = gridDim.x * NTHR, c4 = jl * 4;
        for (int it = gt >> 4; it < MP * 16; it += 4 * (NGT >> 4)) {
            u32x2 ow[4], vw[4], gw[4]; float bd[4]; int itx[4];
#pragma unroll
            for (int u = 0; u < 4; ++u) { const int ii = it + u * (NGT >> 4); itx[u] = ii < MP * 16 ? ii : it; const size_t oo = (size_t)(itx[u] >> 4) * D + (itx[u] & 15) * 64 + c4;
                ow[u] = *(const u32x2*)(ORAW + oo); vw[u] = *(const u32x2*)(Vg + oo); gw[u] = *(const u32x2*)(GG + oo); bd[u] = BD[itx[u]]; }
#pragma unroll
            for (int u = 0; u < 4; ++u) { const int h = itx[u] & 15; const size_t oo = (size_t)(itx[u] >> 4) * D + h * 64 + c4;
                const f32x4 ov = unpk4(ow[u]), v4 = unpk4(vw[u]), g4 = unpk4(gw[u]);
                const f32x4 lnw = *(const f32x4*)(a.in[I_RWLNW] + h * 64 + c4), lnb = *(const f32x4*)(a.in[I_RWLNB] + h * 64 + c4);
                float sm = (ov[0] + ov[1]) + (ov[2] + ov[3]); sm = row16_sum(sm); const float mean = sm * (1.f / 64.f); const f32x4 dv = ov - mean;
                float vr = (dv[0] * dv[0] + dv[1] * dv[1]) + (dv[2] * dv[2] + dv[3] * dv[3]); vr = row16_sum(vr); const float rstd = 1.f / sqrtf(vr * (1.f / 64.f) + 64e-5f);
                const f32x4 res = (dv * rstd * lnw + lnb + v4 * bd[u]) * g4;
                if (u == 0 || it + u * (NGT >> 4) < MP * 16) *(u32x2*)(Rg + oo) = pk4(res); }
        }
    }
    __syncthreads();
    for (int item = obid(); item < 128 * 16; item += gridDim.x) {
        const int bs = item >> 4, h = item & 15, row = MP + bs; const size_t offj = (size_t)row * D + h * 64 + jl * 4;
        const f32x4 kkc = *(const f32x4*)(a.in[I_RWKK] + h * 64 + jl * 4), kac = *(const f32x4*)(a.in[I_RWKA] + h * 64 + jl * 4), rkc = *(const f32x4*)(a.in[I_RWRK] + h * 64 + jl * 4);
        const RwPrep pp = rw_prep(*(const u32x2*)(Rg + offj), *(const u32x2*)(Kg + offj), *(const u32x2*)(DEC + offj), *(const u32x2*)(AA + offj), kkc, kac, rkc);
        const float v0 = bf1(Vg[(size_t)row * D + h * 64 + i0]), v1 = bf1(Vg[(size_t)row * D + h * 64 + i1]);
        const size_t oo_ = (size_t)row * D + h * 64 + (tid & 15) * 4; const u32x2 vpre = *(const u32x2*)(Vg + oo_), gpre = *(const u32x2*)(GG + oo_);
        const size_t sidx = ((size_t)item * 64 + i0) * 64 + jl * 4;
        f32x4 S0 = *(const f32x4*)(a.in[I_WKV] + sidx), S1 = *(const f32x4*)(a.in[I_WKV] + sidx + 64);
        float p0 = (S0[0] * pp.nk[0] + S0[1] * pp.nk[1]) + (S0[2] * pp.nk[2] + S0[3] * pp.nk[3]), p1 = (S1[0] * pp.nk[0] + S1[1] * pp.nk[1]) + (S1[2] * pp.nk[2] + S1[3] * pp.nk[3]);
        p0 = row16_sum(p0); p1 = row16_sum(p1);
        S0 = S0 * pp.w + pp.ka * p0 + pp.kp * v0; S1 = S1 * pp.w + pp.ka * p1 + pp.kp * v1;
        *(f32x4*)(a.out + O_WKV_S + sidx) = S0; *(f32x4*)(a.out + O_WKV_S + sidx + 64) = S1;
        float q0 = (S0[0] * pp.r[0] + S0[1] * pp.r[1]) + (S0[2] * pp.r[2] + S0[3] * pp.r[3]), q1 = (S1[0] * pp.r[0] + S1[1] * pp.r[1]) + (S1[2] * pp.r[2] + S1[3] * pp.r[3]);
        q0 = row16_sum(q0); q1 = row16_sum(q1);
        if (jl == 0) { OL[i0] = q0; OL[i1] = q1; }
        __syncthreads();
        if (tid < 16) { const int cc = tid * 4; const size_t oo = (size_t)row * D + h * 64 + cc;
            const f32x4 ov = *(const LAS f32x4*)(OL + cc), v4 = unpk4(vpre), g4 = unpk4(gpre);
            const f32x4 lnw = *(const f32x4*)(a.in[I_RWLNW] + h * 64 + cc), lnb = *(const f32x4*)(a.in[I_RWLNB] + h * 64 + cc);
            float sm = (ov[0] + ov[1]) + (ov[2] + ov[3]); sm = row16_sum(sm); const float mean = sm * (1.f / 64.f); const f32x4 dv = ov - mean;
            float vr = (dv[0] * dv[0] + dv[1] * dv[1]) + (dv[2] * dv[2] + dv[3] * dv[3]); vr = row16_sum(vr); const float rstd = 1.f / sqrtf(vr * (1.f / 64.f) + 64e-5f);
            const f32x4 res = (dv * rstd * lnw + lnb + v4 * pp.bd) * g4; *(u32x2*)(Rg + oo) = pk4(res); }
        __syncthreads();
    }
}

__device__ __forceinline__ void lru_conv_phase(ArgsR a) {
    const int gt = obid() * NTHR + otid(), NGT = gridDim.x * NTHR;
    const bf16_t* UPRE = WSB(WS_AR + AR_UPRE); bf16_t* U = WSB(WS_AR + AR_U); const float* cw = a.in[I_LCW]; const float* cb = a.in[I_LCB];
    for (int it = gt; it < (MP / 4) * 128; it += NGT) {
        const int row0 = (it >> 7) * 4, c = (it & 127) * 8, l0 = row0 & (LSEQ - 1);
        u32x4 g[7]; const u32x4 z = {0, 0, 0, 0};
#pragma unroll
        for (int r = 0; r < 3; ++r) g[r] = l0 ? *(const u32x4*)(UPRE + (size_t)(row0 - 3 + r) * D + c) : z;
#pragma unroll
        for (int r = 0; r < 4; ++r) g[3 + r] = *(const u32x4*)(UPRE + (size_t)(row0 + r) * D + c);
        float w[4][8], bb[8], x[7][8];
#pragma unroll
        for (int e = 0; e < 8; ++e) { bb[e] = cb[c + e];
#pragma unroll
            for (int k = 0; k < 4; ++k) w[k][e] = cw[k * D + c + e]; }
#pragma unroll
        for (int r = 0; r < 7; ++r) unpk8(g[r], x[r]);
#pragma unroll
        for (int r = 0; r < 4; ++r) { float o[8];
#pragma unroll
            for (int e = 0; e < 8; ++e) o[e] = bb[e] + x[r][e] * w[0][e] + x[r + 1][e] * w[1][e] + x[r + 2][e] * w[2][e] + x[r + 3][e] * w[3][e];
            u32x4 ov; ov.x = pk2(o[0], o[1]); ov.y = pk2(o[2], o[3]); ov.z = pk2(o[4], o[5]); ov.w = pk2(o[6], o[7]);
            *(u32x4*)(U + (size_t)(row0 + r) * D + c) = ov; }
        if (l0 == LSEQ - 4) { float* o = a.out + O_LC_P + ((size_t)(row0 >> 11) * 3) * D + c;
#pragma unroll
            for (int e = 0; e < 8; ++e) { o[e] = x[4][e]; o[D + e] = x[5][e]; o[2 * D + e] = x[6][e]; } }
    }
    for (int it = gt; it < MS * 256; it += NGT) {
        const int bs = it >> 8, c = (it & 255) * 4, row = MP + bs; f32x4 x[4];
        x[3] = unpk4(*(const u32x2*)(UPRE + (size_t)row * D + c));
        const float* st = a.in[I_LC] + (size_t)bs * 3 * D + c; float* o = a.out + O_LC_S + (size_t)bs * 3 * D + c;
#pragma unroll
        for (int k = 0; k < 3; ++k) x[k] = *(const f32x4*)(st + k * D);
        *(f32x4*)o = x[1]; *(f32x4*)(o + D) = x[2]; *(f32x4*)(o + 2 * D) = x[3];
        f32x4 r = *(const f32x4*)(cb + c);
#pragma unroll
        for (int k = 0; k < 4; ++k) r += x[k] * *(const f32x4*)(cw + k * D + c);
        *(u32x2*)(U + (size_t)row * D + c) = pk4(r);
    }
}
__device__ __forceinline__ void lru_scan1_phase(ArgsR a, bool st = true) {
    const int gt = obid() * NTHR + otid(), NGT = gridDim.x * NTHR; constexpr int NIT = 8 * 32 * 1024;
    const float* AF = WSF(WS_AR + AR_AF); const bf16_t* BX = WSB(WS_AR + AR_BX); bf16_t* GATE = WSB(WS_AR + AR_GATE); float* CAR = WSF(WS_CAR);
    for (int id = gt; id < NIT; id += 2 * NGT) {
        const int id1 = id + NGT < NIT ? id + NGT : id; size_t o[2]; float ap[2] = {1.f, 1.f}, h[2] = {0.f, 0.f};
        o[0] = (size_t)((id >> 15) * LSEQ + ((id >> 10) & 31) * 64) * D + (id & 1023); o[1] = (size_t)((id1 >> 15) * LSEQ + ((id1 >> 10) & 31) * 64) * D + (id1 & 1023);
#pragma unroll 1
        for (int t0 = 0; t0 < 64; t0 += 8) { float av[2][8], bv[2][8];
#pragma unroll
            for (int u = 0; u < 2; ++u)
#pragma unroll
                for (int t = 0; t < 8; ++t) { av[u][t] = AF[o[u] + (size_t)t * D]; bv[u][t] = bf1(BX[o[u] + (size_t)t * D]); }
#pragma unroll
            for (int u = 0; u < 2; ++u) {
#pragma unroll
                for (int t = 0; t < 8; ++t) { h[u] = av[u][t] * h[u] + bv[u][t]; ap[u] *= av[u][t]; }
                o[u] += (size_t)8 * D; } }
        *(f32x2*)(CAR + (size_t)id * 2) = (f32x2){ap[0], h[0]}; if (id1 != id) *(f32x2*)(CAR + (size_t)id1 * 2) = (f32x2){ap[1], h[1]};
    }
    if (st)
    for (int id = gt; id < MS * 1024; id += NGT) {
        const int ch = id & 1023, bs = id >> 10; const size_t o = (size_t)(MP + bs) * D + ch;
        const float h = AF[o] * a.in[I_LH][id] + bf1(BX[o]); a.out[O_LH_S + id] = h; GATE[o] = (bf16_t)f2bf(h * bf1(GATE[o]));
    }
}
__device__ __forceinline__ void lru_scan2_phase(ArgsR a, bool st = true) {
    const int gt = obid() * NTHR + otid(), NGT = gridDim.x * NTHR; constexpr int NIT = 8 * 32 * 1024;
    const float* AF = WSF(WS_AR + AR_AF); const bf16_t* BX = WSB(WS_AR + AR_BX); bf16_t* GATE = WSB(WS_AR + AR_GATE); const float* CAR = WSF(WS_CAR);
    (void)st;
    for (int id = gt; id < NIT; id += 2 * NGT) {
        const int id1 = id + NGT < NIT ? id + NGT : id; int idv[2] = {id, id1}; float h[2]; size_t o[2];
#pragma unroll
        for (int u = 0; u < 2; ++u) {
            const int ch = idv[u] & 1023, ck = (idv[u] >> 10) & 31, b = idv[u] >> 15; f32x2 cv[31];
#pragma unroll
            for (int c2 = 0; c2 < 31; ++c2) cv[c2] = *(const f32x2*)(CAR + ((size_t)(b * 32 + c2) * 1024 + ch) * 2);
            float hh = 0.f;
#pragma unroll
            for (int c2 = 0; c2 < 31; ++c2) hh = c2 < ck ? cv[c2].x * hh + cv[c2].y : hh;
            h[u] = hh; o[u] = (size_t)(b * LSEQ + ck * 64) * D + ch;
        }
#pragma unroll 1
        for (int t0 = 0; t0 < 64; t0 += 8) { float av[2][8], bv[2][8], gv[2][8];
#pragma unroll
            for (int u = 0; u < 2; ++u)
#pragma unroll
                for (int t = 0; t < 8; ++t) { av[u][t] = AF[o[u] + (size_t)t * D]; bv[u][t] = bf1(BX[o[u] + (size_t)t * D]); gv[u][t] = bf1(GATE[o[u] + (size_t)t * D]); }
#pragma unroll
            for (int u = 0; u < 2; ++u) { if (u == 1 && id1 == id) break;
#pragma unroll
                for (int t = 0; t < 8; ++t) { h[u] = av[u][t] * h[u] + bv[u][t]; GATE[o[u] + (size_t)t * D] = (bf16_t)f2bf(h[u] * gv[u][t]); }
                o[u] += (size_t)8 * D; } }
#pragma unroll
        for (int u = 0; u < 2; ++u) if (((idv[u] >> 10) & 31) == 31 && (u == 0 || id1 != id)) a.out[O_LH_P + (idv[u] >> 15) * 1024 + (idv[u] & 1023)] = h[u];
    }
}
__device__ __forceinline__ void lru_scan_fused(ArgsR a, LAS unsigned char* lds) {
    const int tid = otid(), ck = tid >> 4, cl = tid & 15;
    const float* AF = WSF(WS_AR + AR_AF); const bf16_t* BX = WSB(WS_AR + AR_BX); bf16_t* GATE = WSB(WS_AR + AR_GATE);
    LAS f32x4* car = (LAS f32x4*)lds;
    for (int item = obid(); item < 256; item += gridDim.x) {
        const int b = item >> 5, ch0 = (item & 31) * 32 + cl * 2; const size_t o0 = (size_t)(b * LSEQ + ck * 64) * D + ch0;
        float ap0 = 1.f, ap1 = 1.f, h0 = 0.f, h1 = 0.f; size_t o = o0;
#pragma unroll 1
        for (int t0 = 0; t0 < 64; t0 += 8) { f32x2 av[8]; unsigned bv[8];
#pragma unroll
            for (int t = 0; t < 8; ++t) { av[t] = *(const f32x2*)(AF + o + (size_t)t * D); bv[t] = *(const unsigned*)(BX + o + (size_t)t * D); }
#pragma unroll
            for (int t = 0; t < 8; ++t) { h0 = av[t].x * h0 + bflo(bv[t]); h1 = av[t].y * h1 + bfhi(bv[t]); ap0 *= av[t].x; ap1 *= av[t].y; }
            o += (size_t)8 * D; }
        __syncthreads();
        car[ck * 16 + cl] = (f32x4){ap0, h0, ap1, h1};
        __syncthreads();
        h0 = 0.f; h1 = 0.f;
        for (int c2 = 0; c2 < ck; ++c2) { const f32x4 cv = car[c2 * 16 + cl]; h0 = cv[0] * h0 + cv[1]; h1 = cv[2] * h1 + cv[3]; }
        o = o0;
#pragma unroll 1
        for (int t0 = 0; t0 < 64; t0 += 8) { f32x2 av[8]; unsigned bv[8], gv[8];
#pragma unroll
            for (int t = 0; t < 8; ++t) { av[t] = *(const f32x2*)(AF + o + (size_t)t * D); bv[t] = *(const unsigned*)(BX + o + (size_t)t * D); gv[t] = *(const unsigned*)(GATE + o + (size_t)t * D); }
#pragma unroll
            for (int t = 0; t < 8; ++t) { h0 = av[t].x * h0 + bflo(bv[t]); h1 = av[t].y * h1 + bfhi(bv[t]); *(unsigned*)(GATE + o + (size_t)t * D) = pk2(h0 * bflo(gv[t]), h1 * bfhi(gv[t])); }
            o += (size_t)8 * D; }
        if (ck == 31) { a.out[O_LH_P + b * 1024 + ch0] = h0; a.out[O_LH_P + b * 1024 + ch0 + 1] = h1; }
    }
    __syncthreads();
    const int gt = obid() * NTHR + tid, NGT = gridDim.x * NTHR;
    for (int id = gt; id < MS * 1024; id += NGT) {
        const int ch = id & 1023, bs = id >> 10; const size_t o = (size_t)(MP + bs) * D + ch;
        const float h = AF[o] * a.in[I_LH][id] + bf1(BX[o]); a.out[O_LH_S + id] = h; GATE[o] = (bf16_t)f2bf(h * bf1(GATE[o]));
    }
}
__device__ __forceinline__ void final_phase(ArgsR a, bool st = true) {
    const int tid = otid(), lane = tid & 63, wave = tid >> 6, gw = obid() * 8 + wave, NGW = gridDim.x * 8;
    const float* SSQ = WSF(WS_SSQ); const float* gm = a.in[I_NFIN];
    (void)st;
    for (int row = gw; row < MA; row += 2 * NGW) {
        const int row2 = row + NGW; const bool has2 = row2 < MA; const int r2 = has2 ? row2 : row;
        float q = SSQ[(size_t)(lane < 32 ? row : r2) * 32 + (lane & 31)]; f32x4 xa[4], xb[4];
#pragma unroll
        for (int qq = 0; qq < 4; ++qq) { xa[qq] = *(const f32x4*)(a.out + (size_t)row * D + lane * 4 + 256 * qq); xb[qq] = *(const f32x4*)(a.out + (size_t)r2 * D + lane * 4 + 256 * qq); }
#pragma unroll
        for (int o = 1; o < 32; o <<= 1) q += __shfl_xor(q, o);
        const float rs1 = rstd_from(__shfl(q, 0)), rs2 = rstd_from(__shfl(q, 32));
#pragma unroll
        for (int qq = 0; qq < 4; ++qq) { const int c = lane * 4 + 256 * qq; const f32x4 g4 = *(const f32x4*)(gm + c);
            *(f32x4*)(a.out + (size_t)row * D + c) = xa[qq] * g4 * rs1; if (has2) *(f32x4*)(a.out + (size_t)row2 * D + c) = xb[qq] * g4 * rs2; }
    }
}


#define XB_TMO      128
#define XB_XCNT(j)  (256  + 64 * (j))
#define XB_XSUB(j)  (1280 + 64 * (j))
#define XB_XGEN(j)  (2304 + 64 * (j))
#define XB_TOP      3328
#define XB_TOPGEN   3392
#define XCD_BAR_WORDS 3456
#define XB_SPIN_CAP (1u << 18)
__device__ __forceinline__ unsigned xb_ld(unsigned* p)              { return __hip_atomic_load(p, __ATOMIC_RELAXED, __HIP_MEMORY_SCOPE_AGENT); }
__device__ __forceinline__ unsigned xb_add(unsigned* p, unsigned v) { return __hip_atomic_fetch_add(p, v, __ATOMIC_RELAXED, __HIP_MEMORY_SCOPE_AGENT); }
__device__ __forceinline__ unsigned xb_xcc_id() { return (unsigned)__builtin_amdgcn_s_getreg((3 << 11) | 20) & 0xFu; }
#define XB_SPIN(cond, bar) do { unsigned _sp = 0; while (cond) { \
    if ((++_sp & 255u) == 0u) { if (xb_ld(&(bar)[XB_TMO])) break; if (_sp > XB_SPIN_CAP) { atomicAdd(&(bar)[XB_TMO], 1u); break; } } } } while (0)
struct XcdBarrier { unsigned* bar; unsigned x; volatile LAS unsigned* st; };
__device__ __forceinline__ XcdBarrier xcd_barrier_post(unsigned* bar, volatile LAS unsigned* st) {
    XcdBarrier b; b.bar = bar; b.x = xb_xcc_id(); b.st = st;
    if (threadIdx.x == 0) (void)xb_add(&bar[XB_XCNT(b.x)], 1u);
    return b;
}
__device__ __forceinline__ void xcd_barrier_complete(unsigned* bar, unsigned x, unsigned& nloc, unsigned& nx) {
    const unsigned G = gridDim.x * gridDim.y * gridDim.z;
    unsigned sum, cnt, mine, sp = 0u;
    for (;;) {
        sum = 0u; cnt = 0u; mine = 0u;
#pragma unroll
        for (unsigned j = 0; j < 16; ++j) { const unsigned c = xb_ld(&bar[XB_XCNT(j)]); sum += c; cnt += (c > 0u) ? 1u : 0u; mine = (j == x) ? c : mine; }
        if (sum == G) break;
        __builtin_amdgcn_s_sleep(1);
        if ((++sp & 255u) == 0u) { if (xb_ld(&bar[XB_TMO])) break; if (sp > XB_SPIN_CAP) { atomicAdd(&bar[XB_TMO], 1u); break; } }
    }
    nloc = mine > 0u ? mine : 1u; nx = cnt > 0u ? cnt : 1u;
}
__device__ __forceinline__ void xcd_barrier(const XcdBarrier& b) {
    asm volatile("s_waitcnt vmcnt(0)" ::: "memory");
    __syncthreads();
    if (threadIdx.x == 0) {
        unsigned* bar = b.bar;
        __builtin_amdgcn_s_waitcnt(0);
        unsigned nloc = b.st[0], nx = b.st[1];
        if (nloc == 0u) { xcd_barrier_complete(bar, b.x, nloc, nx); b.st[0] = nloc; b.st[1] = nx; }
        const unsigned old = xb_add(&bar[XB_XSUB(b.x)], 1u);
        const unsigned gen = old / nloc;
        if (old + 1u == (gen + 1u) * nloc) {
            __builtin_amdgcn_fence(__ATOMIC_RELEASE, "agent");
            asm volatile("s_waitcnt vmcnt(0)" ::: "memory");
            const unsigned og = xb_add(&bar[XB_TOP], 1u);
            const unsigned tg = og / nx;
            if (og + 1u == (tg + 1u) * nx) xb_add(&bar[XB_TOPGEN], 1u);
            else XB_SPIN(xb_ld(&bar[XB_TOPGEN]) == tg, bar);
            __builtin_amdgcn_fence(__ATOMIC_ACQUIRE, "agent");
            xb_add(&bar[XB_XGEN(b.x)], 1u);
            asm volatile("s_waitcnt vmcnt(0)" ::: "memory");
        } else {
            XB_SPIN(xb_ld(&bar[XB_XGEN(b.x)]) == gen, bar);
            __builtin_amdgcn_fence(__ATOMIC_ACQUIRE, "agent");
            asm volatile("s_waitcnt vmcnt(0)" ::: "memory");
        }
    }
    __syncthreads();
}


__device__ __forceinline__ void ffn_fix(ArgsR a, int li) {
    const int tid = otid(); pg8::StaticOrder S; S.init(64, 4, (int)gridDim.x, obid()); pg8::Unit u;
    bf16_t* ACT = WSB(WS_AR + AR_UP); const float* HALO = WSF(WS_AR + AR_G); const float* GFIX = HALO + 64 * 2 * FF; const float* UPFIX = GFIX + 64 * 2 * FF;
    const float* cw = a.in[I_FCW] + (size_t)li * 3 * FF; const float* cb = a.in[I_FCB] + (size_t)li * FF;
    for (int i = 0; S.next(i, u); ++i) {
        const int pm = u.pm; if ((pm & 7) == 0) continue;
        for (int cg = tid; cg < FF / 4; cg += NTHR) {
            const int col = cg * 4;
            const f32x4 gm2 = *(const f32x4*)(HALO + (size_t)((pm - 1) * 2) * FF + col), gm1 = *(const f32x4*)(HALO + (size_t)((pm - 1) * 2 + 1) * FF + col);
            const f32x4 g0 = *(const f32x4*)(GFIX + (size_t)(pm * 2) * FF + col), g1 = *(const f32x4*)(GFIX + (size_t)(pm * 2 + 1) * FF + col);
            const f32x4 u0 = *(const f32x4*)(UPFIX + (size_t)(pm * 2) * FF + col), u1 = *(const f32x4*)(UPFIX + (size_t)(pm * 2 + 1) * FF + col);
            const f32x4 bb = *(const f32x4*)(cb + col), w0 = *(const f32x4*)(cw + col), w1 = *(const f32x4*)(cw + FF + col), w2 = *(const f32x4*)(cw + 2 * FF + col);
            const f32x4 c0 = bb + gm2 * w0 + gm1 * w1 + g0 * w2, c1 = bb + gm1 * w0 + g0 * w1 + g1 * w2; f32x4 o0, o1;
#pragma unroll
            for (int e = 0; e < 4; ++e) { o0[e] = c0[e] * sigmoidf_(c0[e]) * u0[e]; o1[e] = c1[e] * sigmoidf_(c1[e]) * u1[e]; }
            *(u32x2*)(ACT + (size_t)(pm * 256) * FF + col) = pk4(o0); *(u32x2*)(ACT + (size_t)(pm * 256 + 1) * FF + col) = pk4(o1);
        }
    }
    asm volatile("s_waitcnt vmcnt(0)" ::: "memory");
    __syncthreads();
}

#define A2 WSB(WS_AR + AR_A2)
#define YB WSB(WS_AR + AR_YB)
#define HX WSB(WS_AR + AR_HX)
#define RKV WSB(WS_AR + AR_RKV)
#define LORA WSB(WS_AR + AR_LORA)
#define GATE WSB(WS_AR + AR_GATE)
#define UPRE WSB(WS_AR + AR_UPRE)
#define U_ WSB(WS_AR + AR_U)
#define G_ WSB(WS_AR + AR_G)
#define UP_ WSB(WS_AR + AR_UP)
constexpr int LDS_BYTES = 147456;
constexpr int NPHASES = 31;
constexpr int BIG = 1 << 30;

struct EpiNull {
    static constexpr bool IDEMP = false;
    __device__ __forceinline__ void operator()(const f32x4 (&acc)[2][2][4][2], const pg8::Unit&, int, int, int, int) const {
#pragma unroll
        for (int a = 0; a < 2; ++a)
#pragma unroll
            for (int b = 0; b < 2; ++b)
#pragma unroll
                for (int m = 0; m < 4; ++m)
#pragma unroll
                    for (int n = 0; n < 2; ++n) asm volatile("" :: "v"(acc[a][b][m][n]));
    }
};
template <class F>
__device__ __forceinline__ void run_gemm(LAS unsigned char* lds, const pg8::Gemm& g, const F& f, const float* ssq_in, float* ssq_out) {
    pg8::StaticOrder S; S.init(g.nM, g.nN, (int)gridDim.x, obid());
    EpiWrap<F> E{f, ssq_in, ssq_out};
    if (PROBE_GEMM2) { EpiNull N; pg8::gemm_phase<EpiNull>(lds, g, S, N); }
    pg8::gemm_phase<EpiWrap<F>>(lds, g, S, E);
}

__global__ void __launch_bounds__(NTHR, 2) mega(Args a0) {
    extern __shared__ __attribute__((aligned(16))) unsigned char lds_raw[];
    LAS unsigned char* lds = (LAS unsigned char*)lds_raw;
    cg::grid_group grid = cg::this_grid();
    volatile LAS unsigned* misc = (volatile LAS unsigned*)(lds + 131072 + 320);
    if (threadIdx.x < 32) misc[threadIdx.x] = 0u;
    __syncthreads();
    XcdBarrier xbar = xcd_barrier_post((unsigned*)(a0.ws + WS_CTL), misc + 8);
    int k = 0; const int plo = a0.lo, phi = a0.hi;
#define PH(...) do { if (k >= plo && k < phi) { ArgsR a = *opaque_args(); float* X = a.out; bf16_t* XB = WSB(WS_XB); float* SSQ = WSF(WS_SSQ); (void)X; (void)XB; (void)SSQ; __VA_ARGS__; if (k + 1 < phi) { if (phi > NPHASES) grid.sync(); else xcd_barrier(xbar); if (PROBE_SYNC2) xcd_barrier(xbar); } } ++k; } while (0)
    PH( prologue_weights(a, lds); if (PROBE_PRO2) { __syncthreads(); prologue_weights(a, lds); } s5_gen(a, lds, 0); if (PROBE_GEN2) s5_gen(a, lds, 0); );
#pragma nounroll
    for (int li = 0; li < 4; ++li) {
        const int kind = li % 3, j = li / 3;
        if (kind == 0) {
            PH( s5_u_phase(a, li, j); if (PROBE_EW2) s5_u_phase(a, li, j); );
            PH( REP(4) { pg8::Gemm g{A2, WSB(WS_AR + AR_S5A), 384, 256, 256, 256, 1, BIG, 0, 4, 65536}; run_gemm(lds, g, F_S5A{WSF(WS_AR + AR_HLOC)}, nullptr, nullptr); } );
            PH( s5_carry_phase(a, j); if (PROBE_EW2) s5_carry_phase(a, j); );
            PH( REP(4) { pg8::Gemm g{A2, WSB(WS_AR + AR_S5C), 384, 384, 384, 256, 1, BIG, 0, 4, 98304}; run_gemm(lds, g, F_S5C{A2, a.in[I_S5D] + j * 1024, YB}, nullptr, nullptr); } );
            PH( REP(32) { const bf16_t* W = WSB(WS_WGLU) + (size_t)j * 2048 * 1024; pg8::Gemm g{YB, W, 1024, 1024, 1024, 64, 8, BIG, 0, BIG, 0}; F_GLU f{X, XB, (PROBE_PH & 32) && rp_ == 0, li == 0 ? a.in[I_XP] : X, li == 0 ? a.in[I_XS] : X + (size_t)MP * D};
                  run_gemm(lds, g, f, nullptr, SSQ); sample_gemm(lds, YB + (size_t)MP * D, 1024, W, 1024, 32, 1024, MP, f, nullptr, SSQ); } );
        } else if (kind == 1) {
            PH( rw1_phase(a, li); if (PROBE_EW2) rw1_phase(a, li); );
            PH( REP(2) { pg8::Gemm g{HX, WSB(WS_WRW2), 2048, 2048, 2048, 64, 13, BIG, 0, BIG, 0}; F_RW2 f{RKV, LORA};
                  run_gemm(lds, g, f, nullptr, nullptr); sample_gemm(lds, HX + (size_t)MP * 2048, 2048, WSB(WS_WRW2), 2048, 104, 2048, MP, f, nullptr, nullptr, BIG, 0, 832 % (int)gridDim.x);
                  if (rp_ == 0) { const int w0 = 832 % (int)gridDim.x; if (obid() >= w0) convert_items(a, lds, (obid() - w0) * 8 + (otid() >> 6), ((int)gridDim.x - w0) * 8, 1); } } );
            PH( REP(2) { pg8::Gemm g{LORA, WSB(WS_WRW3), 256, 256, 256, 64, 12, BIG, 0, BIG, 0}; F_RW3 f{a.in[I_RWW0], a.in[I_RWA0], WSB(WS_AR + AR_DEC), WSB(WS_AR + AR_AA), WSB(WS_AR + AR_GG)};
                  run_gemm(lds, g, f, nullptr, nullptr); sample_gemm(lds, LORA + (size_t)MP * 256, 256, WSB(WS_WRW3), 256, 96, 256, MP, f, nullptr, nullptr); } );
            PH( rw4_phase(a, lds); );
            PH( rw4b_phase(a, lds); );
            PH( REP(32) { pg8::Gemm g{RKV, WSB(WS_WRWO), 1024, 1024, 1024, 64, 4, BIG, 0, BIG, 0}; F_RES f{X, XB, (PROBE_PH & 32) && rp_ == 0};
                  run_gemm(lds, g, f, nullptr, SSQ); sample_gemm(lds, RKV + (size_t)MP * D, 1024, WSB(WS_WRWO), 1024, 32, 1024, MP, f, nullptr, SSQ); } );
        } else {
            PH( REP(8) { pg8::Gemm g{XB, WSB(WS_WLIN), 1024, 1024, 1024, 64, 8, BIG, 0, BIG, 0}; F_LRUIN f{GATE, UPRE};
                  run_gemm(lds, g, f, SSQ, nullptr); sample_gemm(lds, XB + (size_t)MP * D, 1024, WSB(WS_WLIN), 1024, 32, 1024, MP, f, SSQ, nullptr); } );
            PH( lru_conv_phase(a); if (PROBE_EW2) lru_conv_phase(a); );
            PH( REP(8) { pg8::Gemm g{U_, WSB(WS_WRGIG), 1024, 256, 256, 64, 8, 2, 256, BIG, 0}; F_RGIG f{a.in[I_LBRG], a.in[I_LBIG], WSF(WS_LSL), U_, WSF(WS_AR + AR_AF), WSB(WS_AR + AR_BX)};
                  run_gemm(lds, g, f, nullptr, nullptr); sample_gemm(lds, U_ + (size_t)MP * D, 1024, WSB(WS_WRGIG), 256, 32, 256, MP, f, nullptr, nullptr, 8, 256); } );
            PH( lru_scan_fused(a, lds); );
            PH( REP(32) { pg8::Gemm g{GATE, WSB(WS_WLOUT), 1024, 1024, 1024, 64, 4, BIG, 0, BIG, 0}; F_RES f{X, XB, (PROBE_PH & 32) && rp_ == 0};
                  run_gemm(lds, g, f, nullptr, SSQ); sample_gemm(lds, GATE + (size_t)MP * D, 1024, WSB(WS_WLOUT), 1024, 32, 1024, MP, f, nullptr, SSQ); } );
        }
        PH( REP(1) { const bf16_t* W = WSB(WS_WFIN) + (size_t)li * 5632 * 1024; pg8::Gemm g{XB, W, 1024, 1024, 1024, 64, 22, BIG, 0, BIG, 0};
              const float* cw = a.in[I_FCW] + (size_t)li * 3 * FF; const float* cb = a.in[I_FCB] + (size_t)li * FF; float* HALO = WSF(WS_AR + AR_G);
              { pg8::StaticOrder S; S.init(64, 22, (int)gridDim.x, obid());
                EpiFFN E{UP_, HALO, HALO + 64 * 2 * FF, HALO + 2 * 64 * 2 * FF, SSQ, cw, cb, a.out + O_FC_P + (size_t)li * 8 * 2 * FF, (LAS float*)(lds + 131072 + 1024)};
                pg8::gemm_phase<EpiFFN>(lds, g, S, E); }
              F_FFNIN_S fs{UP_, a.in[I_FC] + (size_t)li * 128 * 2 * FF, a.out + O_FC_S + (size_t)li * 128 * 2 * FF, cw, cb};
              sample_gemm(lds, XB + (size_t)MP * D, 1024, W, 1024, 88, 1024, MP, fs, SSQ, nullptr, BIG, 0, 1408 % (int)gridDim.x);
              if (li == 2) s5_gen(a, lds, 1); } );
        PH( REP(16) { const bf16_t* W = WSB(WS_WFOUT) + (size_t)li * 1024 * 2816; pg8::Gemm g{UP_, W, 2816, 2816, 2816, 64, 4, BIG, 0, BIG, 0}; F_RES f{X, XB, (PROBE_PH & 16) && rp_ == 0};
              ffn_fix(a, li);
              run_gemm(lds, g, f, nullptr, SSQ); sample_gemm(lds, UP_ + (size_t)MP * FF, 2816, W, 2816, 32, 2816, MP, f, nullptr, SSQ); } );
    }
    PH( final_phase(a); );
#undef PH
}

extern "C" void kernel_launch(void* const* d_in, const int* in_sizes, int n_in, void* d_out, int out_size, void* d_ws, size_t ws_size, hipStream_t stream) {
    static int grid = 0;
    if (grid == 0) {
        if (n_in != 50 || (size_t)out_size != O_END || ws_size < WS_END) {
            fprintf(stderr, "kernel_launch: unexpected shapes: n_in %d out %d ws %zu (need %zu)\n", n_in, out_size, ws_size, (size_t)WS_END); grid = -1; return; }
        int dev = 0, cus = 0, per_cu = 0;
        hipGetDevice(&dev); hipDeviceGetAttribute(&cus, hipDeviceAttributeMultiprocessorCount, dev);
        if (hipFuncSetAttribute((const void*)mega, hipFuncAttributeMaxDynamicSharedMemorySize, LDS_BYTES) != hipSuccess) { fprintf(stderr, "kernel_launch: hipFuncSetAttribute failed\n"); grid = -1; return; }
        if (hipOccupancyMaxActiveBlocksPerMultiprocessor(&per_cu, (const void*)mega, NTHR, LDS_BYTES) != hipSuccess || per_cu < 1) { fprintf(stderr, "kernel_launch: occupancy query says %d\n", per_cu); per_cu = 1; }
        (void)hipGetLastError();
        grid = cus * per_cu;
        fprintf(stderr, "kernel_launch: grid %d (cus %d x %d)\n", grid, cus, per_cu);
    }
    if (grid < 0) return;
    Args a{};
    for (int i = 0; i < 50; ++i) a.in[i] = (const float*)d_in[i];
    a.out = (float*)d_out; a.ws = (unsigned char*)d_ws;
#if PER_PHASE_LAUNCH
    for (int k = 0; k < NPHASES; ++k) { a.lo = k; a.hi = k + 1; hipLaunchKernelGGL(mega, dim3(grid), dim3(NTHR), LDS_BYTES, stream, a); }
#else
    if (hipMemsetAsync((char*)d_ws + WS_CTL, 0, XCD_BAR_WORDS * 4, stream) != hipSuccess) { fprintf(stderr, "kernel_launch: memset failed\n"); return; }
    a.lo = 0; a.hi = NPHASES; void* args[] = {&a};
    hipError_t e = hipLaunchCooperativeKernel((const void*)mega, dim3(grid), dim3(NTHR), args, LDS_BYTES, stream);
    if (e != hipSuccess) fprintf(stderr, "cooperative launch failed: %s (grid %d)\n", hipGetErrorString(e), grid);
#endif
}
```

```cpp
#include <hip/hip_runtime.h>
#include <hip/hip_cooperative_groups.h>
#include <cstdio>
#include <cstdint>
namespace cg = cooperative_groups;

#define PROBE_SYNC2 0
#define PROBE_PH 0
#define REP(bit) for (int rp_ = 0; rp_ < ((PROBE_PH & (bit)) ? 2 : 1); ++rp_)
#define PROBE_GEMM2 0
#define PROBE_RW4 0
#define PROBE_EW2 0
#define PROBE_PRO2 0
#define PROBE_CONV2 0
#define PROBE_MISC2 0
#define PROBE_GEN2 0
#define PROBE_SG2 0
#define PROBE_EPI2 0
#ifndef PER_PHASE_LAUNCH
#define PER_PHASE_LAUNCH 0
#endif

#define LAS __attribute__((address_space(3)))
typedef unsigned short bf16_t;
typedef short bf16x8 __attribute__((ext_vector_type(8)));
typedef float f32x4 __attribute__((ext_vector_type(4)));
typedef float f32x2 __attribute__((ext_vector_type(2)));
typedef float f32x16 __attribute__((ext_vector_type(16)));
typedef unsigned u32x4 __attribute__((ext_vector_type(4)));
typedef unsigned u32x2 __attribute__((ext_vector_type(2)));

constexpr int D = 1024, LSEQ = 2048, NB = 8, MP = NB * LSEQ, MS = 128, MA = MP + MS, FF = 2816;
constexpr float RMS_EPS = 1e-6f;
constexpr size_t O_Y = 0;
constexpr size_t O_S5RE_P = (size_t)MA * D;
constexpr size_t O_S5RE_S = O_S5RE_P + 2 * 8 * 4096;
constexpr size_t O_S5IM_P = O_S5RE_S + 2 * 128 * 4096;
constexpr size_t O_S5IM_S = O_S5IM_P + 2 * 8 * 4096;
constexpr size_t O_WKV_P = O_S5IM_S + 2 * 128 * 4096;
constexpr size_t O_WKV_S = O_WKV_P + 8 * 16 * 4096;
constexpr size_t O_SH_P = O_WKV_S + (size_t)128 * 16 * 4096;
constexpr size_t O_SH_S = O_SH_P + 8 * 1024;
constexpr size_t O_LH_P = O_SH_S + 128 * 1024;
constexpr size_t O_LH_S = O_LH_P + 8 * 1024;
constexpr size_t O_LC_P = O_LH_S + 128 * 1024;
constexpr size_t O_LC_S = O_LC_P + 8 * 3 * 1024;
constexpr size_t O_FC_P = O_LC_S + 128 * 3 * 1024;
constexpr size_t O_FC_S = O_FC_P + 4 * 8 * 2 * FF;
constexpr size_t O_END = O_FC_S + (size_t)4 * 128 * 2 * FF;
static_assert(O_END == 31809536, "output size");

constexpr size_t MiB = 1u << 20;
constexpr size_t WS_WGLU = 0, WS_WFIN = 8 * MiB, WS_WFOUT = 52 * MiB, WS_WRW2 = 74 * MiB, WS_WRW3 = 87 * MiB, WS_WRWO = 89 * MiB,
                 WS_WLIN = 91 * MiB, WS_WRGIG = 95 * MiB, WS_WLOUT = 96 * MiB, WS_TBL = 98 * MiB, WS_LSL = 98 * MiB + 512 * 1024,
                 WS_CAR = 99 * MiB, WS_CTL = 101 * MiB, WS_XB = 102 * MiB, WS_SSQ = 135 * MiB, WS_AR = 138 * MiB, WS_END = WS_AR + 204 * MiB;
constexpr size_t AR_G = 0, AR_UP = 89 * MiB;
constexpr size_t AR_A2 = 0, AR_HLOC = 48 * MiB, AR_YB = 80 * MiB;
constexpr size_t AR_S5A = 180 * MiB, AR_S5C = 188 * MiB;
constexpr size_t AR_HX = 0, AR_DEC = 0, AR_AA = 32 * MiB + 512 * 1024, AR_RKV = 65 * MiB, RKV_PLANE = 32 * MiB + 512 * 1024,
                 AR_LORA = AR_RKV + 3 * RKV_PLANE, AR_GG = AR_LORA + 8 * MiB + 512 * 1024;
constexpr size_t AR_GATE = 0, AR_UPRE = 32 * MiB + 512 * 1024, AR_U = 65 * MiB, AR_AF = 97 * MiB + 512 * 1024,
                 AR_BX = 162 * MiB + 512 * 1024;
static_assert(AR_GG + 32 * MiB + 512 * 1024 <= 204 * MiB && AR_BX + 32 * MiB + 512 * 1024 <= 204 * MiB, "arena");

__device__ __forceinline__ int otid() { int t = threadIdx.x; asm volatile("" : "+v"(t)); return t; }
__device__ __forceinline__ int obid() { int t = blockIdx.x; asm volatile("" : "+s"(t)); return t; }

__device__ __forceinline__ unsigned f2bf(float f) { unsigned u = __builtin_bit_cast(unsigned, f); return (u + 0x7fffu + ((u >> 16) & 1u)) >> 16; }
__device__ __forceinline__ unsigned pk2(float lo, float hi) { return f2bf(lo) | (f2bf(hi) << 16); }
__device__ __forceinline__ float bflo(unsigned w) { return __uint_as_float(w << 16); }
__device__ __forceinline__ float bfhi(unsigned w) { return __uint_as_float(w & 0xffff0000u); }
__device__ __forceinline__ float bf1(bf16_t b) { return __uint_as_float((unsigned)b << 16); }
__device__ __forceinline__ u32x2 pk4(f32x4 v) { u32x2 r; r.x = pk2(v[0], v[1]); r.y = pk2(v[2], v[3]); return r; }
__device__ __forceinline__ f32x4 unpk4(u32x2 w) { return (f32x4){bflo(w.x), bfhi(w.x), bflo(w.y), bfhi(w.y)}; }
__device__ __forceinline__ float sigmoidf_(float x) { return 1.f / (1.f + __expf(-x)); }
__device__ __forceinline__ float gelu_tanh(float x) { const float z = 0.7978845608f * (x + 0.044715f * x * x * x); return x / (1.f + __expf(-2.f * z)); }
__device__ __forceinline__ float tanhf_(float x) { return 1.f - 2.f / (__expf(2.f * x) + 1.f); }
__device__ __forceinline__ float wave_sum(float v) {
#pragma unroll
    for (int o = 1; o < 64; o <<= 1) v += __shfl_xor(v, o);
    return v;
}
template <int CTRL> __device__ __forceinline__ float dppf(float x) {
    return __builtin_bit_cast(float, __builtin_amdgcn_update_dpp(0, __builtin_bit_cast(int, x), CTRL, 0xf, 0xf, true));
}
__device__ __forceinline__ float row16_sum(float x) {
    x += dppf<0xB1>(x);
    x += dppf<0x4E>(x);
    x += dppf<0x141>(x);
    x += dppf<0x140>(x);
    return x;
}

namespace pg8 {
constexpr int BM = 256, BK = 64, HALF = 128, HTB = HALF * BK * 2, STAGE_BYTES = 8 * HTB, NXCD = 8, WGM = 8;
__host__ __device__ __forceinline__ int lds_byte(int r, int c) { const int st = (r >> 4) * 2 + (c >> 5), rr = r & 15, cc = c & 31, ob = rr * 64 + cc * 2; return st * 1024 + (ob ^ (((ob >> 9) & 1) << 5)); }
__host__ __device__ __forceinline__ void stage_rc(int b, int& R, int& C) { const int st = b / 1024, sb = b % 1024, swz = sb ^ (((sb >> 9) & 1) << 5); R = (st >> 1) * 16 + swz / 64; C = (st & 1) * 32 + (swz % 64) / 2; }
__host__ __device__ __forceinline__ int perm32(int rho) { const int n = rho >> 4, i = rho & 15; return 8 * (i >> 2) + 4 * n + (i & 3); }

struct Unit { int pm, pn; };
struct Gemm { const bf16_t* A; const bf16_t* Bt; int lda, ldb, K, nM, nN; int a_ndiv; int a_nstride; int b_mdiv; int b_mstride; };
__device__ __forceinline__ const char* a_base(const Gemm& g, const Unit& u) { return (const char*)(g.A + (size_t)u.pm * 256 * g.lda + (size_t)(u.pn / g.a_ndiv) * g.a_nstride); }
__device__ __forceinline__ const char* b_base(const Gemm& g, const Unit& u) { return (const char*)(g.Bt + (size_t)u.pn * 256 * g.ldb + (size_t)(u.pm / g.b_mdiv) * g.b_mstride); }

struct StaticOrder {
    int nM, nN, nwg, G, c;
    __device__ void init(int nM_, int nN_, int G_, int c_) { nM = nM_; nN = nN_; nwg = nM * nN; G = G_; c = c_; }
    __device__ bool next(int i, Unit& u) const {
        const long L = (long)i * G + c; if (L >= nwg) return false;
        int wgid = (int)L; { const int q = nwg / NXCD, r = nwg % NXCD, xcd = wgid % NXCD, off = wgid / NXCD; wgid = (xcd < r ? xcd * (q + 1) : r * (q + 1) + (xcd - r) * q) + off; }
        const int nig = WGM * nN, gid = wgid / nig, fm = gid * WGM, gsz = (nM - fm) < WGM ? (nM - fm) : WGM;
        u.pm = fm + ((wgid % nig) % gsz); u.pn = (wgid % nig) / gsz; return true;
    }
};

template <class Epi>
__device__ __forceinline__ void gemm_phase(LAS unsigned char* lds, const Gemm g, const StaticOrder& S, const Epi& E) {
    const int tid = otid(), wid = __builtin_amdgcn_readfirstlane(tid >> 6), lane = tid & 63, wr = wid >> 2, wc = wid & 3, fr = lane & 15, fq = lane >> 4;
    const int K = g.K, nt = K / BK;
    unsigned voffA[2], voffB[2];
#pragma unroll
    for (int i = 0; i < 2; ++i) { int R, C; stage_rc(tid * 16 + i * 8192, R, C); const int Rb = (R & ~31) + perm32(R & 31);
        voffA[i] = (unsigned)(R * g.lda + C) * 2u; voffB[i] = (unsigned)(Rb * g.ldb + C) * 2u; }
    const size_t kstep = (size_t)(BK * 2);
    const size_t hstepA = (size_t)HALF * g.lda * 2, hstepB = (size_t)HALF * g.ldb * 2;
    const unsigned ldsw = (unsigned)wid * 1024u;
    const int aoff = lds_byte(wr * 64 + fr, fq * 8), boff = lds_byte(wc * 32 + fr, fq * 8);
#define PG8_SA(b, h) (((b) * 2 + (h)) * HTB)
#define PG8_SB(b, h) ((4 + (b) * 2 + (h)) * HTB)
#define PG8_STAGE(bufoff, gbase, voff) do { _Pragma("unroll") for (int _i = 0; _i < 2; ++_i) \
        __builtin_amdgcn_global_load_lds((const unsigned*)((const char*)(gbase) + (voff)[_i]), (LAS unsigned*)(lds + (bufoff) + ldsw + _i * 8192), 16, 0, 0); } while (0)
#define PG8_LDA(dst, b, h) do { _Pragma("unroll") for (int m = 0; m < 4; ++m) _Pragma("unroll") for (int k = 0; k < 2; ++k) dst[m][k] = *(const LAS bf16x8*)(lds + PG8_SA(b, h) + aoff + m * 2048 + k * 1024); } while (0)
#define PG8_LDB(dst, b, h) do { _Pragma("unroll") for (int n = 0; n < 2; ++n) _Pragma("unroll") for (int k = 0; k < 2; ++k) dst[n][k] = *(const LAS bf16x8*)(lds + PG8_SB(b, h) + boff + n * 2048 + k * 1024); } while (0)
#define PG8_MMA(ai, bj, At, Bt) do { __builtin_amdgcn_s_setprio(1); _Pragma("unroll") for (int m = 0; m < 4; ++m) _Pragma("unroll") for (int n = 0; n < 2; ++n) _Pragma("unroll") for (int k = 0; k < 2; ++k) \
        acc[ai][bj][m][n] = __builtin_amdgcn_mfma_f32_16x16x32_bf16(Bt[n][k], At[m][k], acc[ai][bj][m][n], 0, 0, 0); __builtin_amdgcn_s_setprio(0); } while (0)
#define PG8_WAIT_V(n) asm volatile("s_waitcnt vmcnt(" #n ")" ::: "memory")
#define PG8_WAIT_L(n) asm volatile("s_waitcnt lgkmcnt(" #n ")" ::: "memory")
#define PG8_BAR __builtin_amdgcn_s_barrier()
#define PG8_SCHED __builtin_amdgcn_sched_barrier(0)
    Unit cur, nxt; int ui = 0;
    if (!S.next(0, cur)) return;
    f32x4 acc[2][2][4][2];
#pragma unroll
    for (int a = 0; a < 2; ++a)
#pragma unroll
        for (int b = 0; b < 2; ++b)
#pragma unroll
            for (int m = 0; m < 4; ++m)
#pragma unroll
                for (int n = 0; n < 2; ++n) acc[a][b][m][n] = (f32x4){0.f, 0.f, 0.f, 0.f};
    bf16x8 At[4][2], B0[2][2], B1[2][2];
    const char* cA = a_base(g, cur); const char* cB = b_base(g, cur);
    PG8_STAGE(PG8_SB(0, 0), cB, voffB); PG8_STAGE(PG8_SB(0, 1), cB + hstepB, voffB); PG8_STAGE(PG8_SA(0, 0), cA, voffA); PG8_STAGE(PG8_SA(0, 1), cA + hstepA, voffA);
    if (wr == 1) PG8_BAR;
    PG8_WAIT_V(2); PG8_BAR;
    PG8_STAGE(PG8_SB(1, 0), cB + kstep, voffB); PG8_STAGE(PG8_SA(1, 0), cA + kstep, voffA); PG8_STAGE(PG8_SB(1, 1), cB + hstepB + kstep, voffB);
    PG8_WAIT_V(6); PG8_BAR;
    for (;;) {
        const bool has_next = S.next(ui + 1, nxt);
        const char* nA = has_next ? a_base(g, nxt) : cA; const char* nB = has_next ? b_base(g, nxt) : cB;
        for (int t = 0; t < nt; t += 2) {
            const bool last = (t == nt - 2);
            const char* a1 = cA + (size_t)(t + 1) * kstep;
            const char* a2 = last ? nA : cA + (size_t)(t + 2) * kstep; const char* b2 = last ? nB : cB + (size_t)(t + 2) * kstep;
            const char* a3 = a2 + kstep; const char* b3 = b2 + kstep;
            PG8_LDB(B0, 0, 0); PG8_LDB(B1, 0, 1); PG8_SCHED; PG8_LDA(At, 0, 0); PG8_STAGE(PG8_SA(1, 1), a1 + hstepA, voffA);
            PG8_WAIT_V(8); PG8_WAIT_L(0); PG8_BAR; PG8_MMA(0, 0, At, B0); PG8_MMA(0, 1, At, B1); PG8_BAR; PG8_SCHED;
            PG8_LDA(At, 0, 1); PG8_STAGE(PG8_SB(0, 0), b2, voffB); PG8_STAGE(PG8_SB(0, 1), b2 + hstepB, voffB); PG8_STAGE(PG8_SA(0, 0), a2, voffA);
            PG8_WAIT_V(8); PG8_WAIT_L(0); PG8_BAR; PG8_MMA(1, 0, At, B0); PG8_MMA(1, 1, At, B1); PG8_BAR; PG8_SCHED;
            PG8_LDB(B0, 1, 0); PG8_LDB(B1, 1, 1); PG8_SCHED; PG8_LDA(At, 1, 0); PG8_STAGE(PG8_SA(0, 1), a2 + hstepA, voffA);
            PG8_WAIT_V(8); PG8_WAIT_L(0); PG8_BAR; PG8_MMA(0, 0, At, B0); PG8_MMA(0, 1, At, B1); PG8_BAR; PG8_SCHED;
            PG8_LDA(At, 1, 1); PG8_STAGE(PG8_SB(1, 0), b3, voffB); PG8_STAGE(PG8_SB(1, 1), b3 + hstepB, voffB); PG8_STAGE(PG8_SA(1, 0), a3, voffA);
            PG8_WAIT_V(8); PG8_WAIT_L(0); PG8_BAR; PG8_MMA(1, 0, At, B0); PG8_MMA(1, 1, At, B1); PG8_BAR; PG8_SCHED;
        }
        if (wr == 0) PG8_BAR;
        E(acc, cur, wr, wc, fr, fq);
        if (PROBE_EPI2 && Epi::IDEMP) E(acc, cur, wr, wc, fr, fq);
        if (!has_next) break;
#pragma unroll
        for (int a = 0; a < 2; ++a)
#pragma unroll
            for (int b = 0; b < 2; ++b)
#pragma unroll
                for (int m = 0; m < 4; ++m)
#pragma unroll
                    for (int n = 0; n < 2; ++n) acc[a][b][m][n] = (f32x4){0.f, 0.f, 0.f, 0.f};
        cur = nxt; cA = nA; cB = nB; ++ui;
        if (wr == 1) PG8_BAR;
    }
    PG8_WAIT_V(0);
    PG8_BAR;
#undef PG8_SA
#undef PG8_SB
#undef PG8_STAGE
#undef PG8_LDA
#undef PG8_LDB
#undef PG8_MMA
#undef PG8_WAIT_V
#undef PG8_WAIT_L
#undef PG8_BAR
#undef PG8_SCHED
}
}

__device__ __forceinline__ float rstd_from(float s) { return 1.f / sqrtf(s * (1.f / D) + RMS_EPS); }

struct NoPre {};
template <class F> struct EpiWrap {
    static constexpr bool IDEMP = !F::HAS_SSQ;
    F f; const float* ssq_in; float* ssq_out;
    __device__ __forceinline__ void operator()(const f32x4 (&acc)[2][2][4][2], const pg8::Unit& u, int wr, int wc, int fr, int fq) const {
        const f32x4 z = {0.f, 0.f, 0.f, 0.f};
        constexpr int NCG = F::PAIRED ? 1 : 2;
        int colg[NCG]; typename F::CP cp[NCG];
#pragma unroll
        for (int c = 0; c < NCG; ++c) { colg[c] = F::PAIRED ? u.pn * 128 + wc * 32 + fq * 8 : u.pn * 256 + c * 128 + wc * 32 + fq * 8; cp[c] = f.cpre(u.pm * 256, colg[c]); }
#pragma unroll
        for (int ai = 0; ai < 2; ++ai) {
            typename F::RP rp[4][NCG]; f32x4 sa[4], sb[4];
#pragma unroll
            for (int m = 0; m < 4; ++m) {
                const int row = u.pm * 256 + ai * 128 + wr * 64 + m * 16 + fr;
                if (F::NEED_RSTD) { sa[m] = *(const f32x4*)(ssq_in + (size_t)row * 32 + fq * 8); sb[m] = *(const f32x4*)(ssq_in + (size_t)row * 32 + fq * 8 + 4); }
#pragma unroll
                for (int c = 0; c < NCG; ++c) rp[m][c] = f.rpre(row, colg[c]);
            }
#pragma unroll
            for (int m = 0; m < 4; ++m) {
                const int row = u.pm * 256 + ai * 128 + wr * 64 + m * 16 + fr;
                float rs = 1.f;
                if (F::NEED_RSTD) { float s = (sa[m][0] + sa[m][1]) + (sa[m][2] + sa[m][3]) + (sb[m][0] + sb[m][1]) + (sb[m][2] + sb[m][3]); s += __shfl_xor(s, 16); s += __shfl_xor(s, 32); rs = rstd_from(s); }
                if (F::PAIRED) {
                    float q = f.fin(row, colg[0], acc[ai][0][m][0], acc[ai][0][m][1], acc[ai][1][m][0], acc[ai][1][m][1], rs, cp[0], rp[m][0]);
                    if (F::HAS_SSQ) { q += __shfl_xor(q, 16); q += __shfl_xor(q, 32); if (fq == 0) ssq_out[(size_t)row * 32 + u.pn * 4 + wc] = q; }
                } else {
#pragma unroll
                    for (int bj = 0; bj < 2; ++bj) {
                        float q = f.fin(row, colg[bj], acc[ai][bj][m][0], acc[ai][bj][m][1], z, z, rs, cp[bj], rp[m][bj]);
                        if (F::HAS_SSQ) { q += __shfl_xor(q, 16); q += __shfl_xor(q, 32); if (fq == 0) ssq_out[(size_t)row * 32 + u.pn * 8 + bj * 4 + wc] = q; }
                    }
                }
            }
        }
    }
};
__device__ __forceinline__ u32x4 pk8(f32x4 a, f32x4 b) { u32x4 r; r.x = pk2(a[0], a[1]); r.y = pk2(a[2], a[3]); r.z = pk2(b[0], b[1]); r.w = pk2(b[2], b[3]); return r; }
__device__ __forceinline__ float ssq4(f32x4 x) { return (x[0] * x[0] + x[1] * x[1]) + (x[2] * x[2] + x[3] * x[3]); }
#define UNPK8(WW_, lo, hi) const f32x4 lo = {bflo((WW_)[0]), bfhi((WW_)[0]), bflo((WW_)[1]), bfhi((WW_)[1])}, hi = {bflo((WW_)[2]), bfhi((WW_)[2]), bflo((WW_)[3]), bfhi((WW_)[3])}
struct X8 { f32x4 x0, x1; };
struct U8 { u32x4 w; };
struct C24 { f32x4 a0, a1, b0, b1, c0, c1; };

struct F_RES {
    static constexpr bool PAIRED = false, NEED_RSTD = false, HAS_SSQ = true;
    typedef NoPre CP; typedef X8 RP;
    float* X; bf16_t* XB; bool dry = false;
    __device__ __forceinline__ CP cpre(int, int) const { return CP{}; }
    __device__ __forceinline__ RP rpre(int row, int col) const { const float* xp = X + (size_t)row * D + col; return RP{*(const f32x4*)xp, *(const f32x4*)(xp + 4)}; }
    __device__ __forceinline__ float fin(int row, int col, f32x4 a0, f32x4 a1, f32x4, f32x4, float, const CP&, const RP& r) const {
        float* xp = X + (size_t)row * D + col; const f32x4 x0 = r.x0 + a0, x1 = r.x1 + a1; *(f32x4*)xp = dry ? r.x0 : x0; *(f32x4*)(xp + 4) = dry ? r.x1 : x1;
        *(u32x4*)(XB + (size_t)row * D + col) = pk8(x0, x1); return ssq4(x0) + ssq4(x1);
    }
};
struct F_GLU {
    static constexpr bool PAIRED = true, NEED_RSTD = false, HAS_SSQ = true;
    typedef NoPre CP; typedef X8 RP;
    float* X; bf16_t* XB; bool dry = false; const float* Xp = nullptr; const float* Xs = nullptr;
    __device__ __forceinline__ CP cpre(int, int) const { return CP{}; }
    __device__ __forceinline__ RP rpre(int row, int col) const { const float* xp = (row < MP ? Xp + (size_t)row * D : Xs + (size_t)(row - MP) * D) + col; return RP{*(const f32x4*)xp, *(const f32x4*)(xp + 4)}; }
    __device__ __forceinline__ float fin(int row, int col, f32x4 a0, f32x4 a1, f32x4 b0, f32x4 b1, float, const CP&, const RP& r) const {
        float* xp = X + (size_t)row * D + col; f32x4 x0 = r.x0, x1 = r.x1;
#pragma unroll
        for (int e = 0; e < 4; ++e) { x0[e] += a0[e] * sigmoidf_(b0[e]); x1[e] += a1[e] * sigmoidf_(b1[e]); }
        *(f32x4*)xp = dry ? r.x0 : x0; *(f32x4*)(xp + 4) = dry ? r.x1 : x1; *(u32x4*)(XB + (size_t)row * D + col) = pk8(x0, x1); return ssq4(x0) + ssq4(x1);
    }
};
struct F_FFNIN {
    static constexpr bool PAIRED = true, NEED_RSTD = true, HAS_SSQ = false;
    typedef NoPre CP; typedef NoPre RP;
    bf16_t* G; bf16_t* UP;
    __device__ __forceinline__ CP cpre(int, int) const { return CP{}; }
    __device__ __forceinline__ RP rpre(int, int) const { return RP{}; }
    __device__ __forceinline__ float fin(int row, int col, f32x4 a0, f32x4 a1, f32x4 b0, f32x4 b1, float rs, const CP&, const RP&) const {
        *(u32x4*)(G + (size_t)row * FF + col) = pk8(a0 * rs, a1 * rs); *(u32x4*)(UP + (size_t)row * FF + col) = pk8(b0 * rs, b1 * rs); return 0.f;
    }
};
struct F_LRUIN {
    static constexpr bool PAIRED = true, NEED_RSTD = true, HAS_SSQ = false;
    typedef NoPre CP; typedef NoPre RP;
    bf16_t* GATEp; bf16_t* UPREp;
    __device__ __forceinline__ CP cpre(int, int) const { return CP{}; }
    __device__ __forceinline__ RP rpre(int, int) const { return RP{}; }
    __device__ __forceinline__ float fin(int row, int col, f32x4 a0, f32x4 a1, f32x4 b0, f32x4 b1, float rs, const CP&, const RP&) const {
        f32x4 g0, g1;
#pragma unroll
        for (int e = 0; e < 4; ++e) { g0[e] = gelu_tanh(a0[e] * rs); g1[e] = gelu_tanh(a1[e] * rs); }
        *(u32x4*)(GATEp + (size_t)row * D + col) = pk8(g0, g1); *(u32x4*)(UPREp + (size_t)row * D + col) = pk8(b0 * rs, b1 * rs); return 0.f;
    }
};
struct F_RGIG {
    static constexpr bool PAIRED = true, NEED_RSTD = false, HAS_SSQ = false;
    typedef C24 CP; typedef U8 RP;
    const float* brg; const float* big; const float* lsl; const bf16_t* U; float* AF; bf16_t* BX;
    __device__ __forceinline__ CP cpre(int, int col) const { return CP{*(const f32x4*)(brg + col), *(const f32x4*)(brg + col + 4), *(const f32x4*)(big + col), *(const f32x4*)(big + col + 4), *(const f32x4*)(lsl + col), *(const f32x4*)(lsl + col + 4)}; }
    __device__ __forceinline__ RP rpre(int row, int col) const { return RP{*(const u32x4*)(U + (size_t)row * D + col)}; }
    __device__ __forceinline__ void half(f32x4 b0, f32x4 b1, f32x4 ls, f32x4 v0, f32x4 v1, f32x4 uu, f32x4& a, f32x4& bx) const {
#pragma unroll
        for (int e = 0; e < 4; ++e) { const float rg = sigmoidf_(v0[e] + b0[e]), ig = sigmoidf_(v1[e] + b1[e]); const float la = rg * ls[e];
            a[e] = __expf(la); const float m2 = 1.f - __expf(2.f * la); bx[e] = sqrtf(m2 > 0.f ? m2 : 0.f) * ig * uu[e]; }
    }
    __device__ __forceinline__ float fin(int row, int col, f32x4 a0, f32x4 a1, f32x4 b0, f32x4 b1, float, const CP& c, const RP& r) const {
        UNPK8(r.w, u0, u1); f32x4 r0, r1, x0, x1;
        half(c.a0, c.b0, c.c0, a0, b0, u0, r0, x0); half(c.a1, c.b1, c.c1, a1, b1, u1, r1, x1);
        *(f32x4*)(AF + (size_t)row * D + col) = r0; *(f32x4*)(AF + (size_t)row * D + col + 4) = r1; *(u32x4*)(BX + (size_t)row * D + col) = pk8(x0, x1); return 0.f;
    }
};
struct F_RW2 {
    static constexpr bool PAIRED = false, NEED_RSTD = false, HAS_SSQ = false;
    typedef NoPre CP; typedef NoPre RP;
    bf16_t* RKVp; bf16_t* LORAp;
    __device__ __forceinline__ CP cpre(int, int) const { return CP{}; }
    __device__ __forceinline__ RP rpre(int, int) const { return RP{}; }
    __device__ __forceinline__ float fin(int row, int col, f32x4 a0, f32x4 a1, f32x4, f32x4, float, const CP&, const RP&) const {
        if (col < 3072) { const int j = col >> 10, c = col & 1023; *(u32x4*)(RKVp + (size_t)j * (RKV_PLANE / 2) + (size_t)row * D + c) = pk8(a0, a1); }
        else { const int c = col - 3072; f32x4 o0, o1;
#pragma unroll
            for (int e = 0; e < 4; ++e) { o0[e] = c < 64 ? tanhf_(a0[e]) : (c < 128 ? a0[e] : sigmoidf_(a0[e])); o1[e] = c < 64 ? tanhf_(a1[e]) : (c < 128 ? a1[e] : sigmoidf_(a1[e])); }
            *(u32x4*)(LORAp + (size_t)row * 256 + c) = pk8(o0, o1); }
        return 0.f;
    }
};
struct F_RW3 {
    static constexpr bool PAIRED = false, NEED_RSTD = false, HAS_SSQ = false;
    typedef X8 CP; typedef NoPre RP;
    const float* w0; const float* a0p; bf16_t* DEC; bf16_t* AA; bf16_t* GG;
    __device__ __forceinline__ CP cpre(int, int col) const { const int j = col >> 10, c = col & 1023; const float* p = j == 0 ? w0 + c : a0p + c; if (j == 2) p = w0; return CP{*(const f32x4*)p, *(const f32x4*)(p + 4)}; }
    __device__ __forceinline__ RP rpre(int, int) const { return RP{}; }
    __device__ __forceinline__ f32x4 dec4(f32x4 w, f32x4 v) const { f32x4 o;
#pragma unroll
        for (int e = 0; e < 4; ++e) { const float z = w[e] + v[e]; const float ew = 0.60653066f / (1.f + __expf(-z)); o[e] = ew < 1e-3f ? ew * (1.f - 0.5f * ew) : 1.f - __expf(-ew); }
        return o; }
    __device__ __forceinline__ f32x4 sig4(f32x4 w, f32x4 v) const { f32x4 o;
#pragma unroll
        for (int e = 0; e < 4; ++e) o[e] = sigmoidf_(w[e] + v[e]);
        return o; }
    __device__ __forceinline__ float fin(int row, int col, f32x4 a0, f32x4 a1, f32x4, f32x4, float, const CP& cp, const RP&) const {
        const int j = col >> 10, c = col & 1023;
        if (j == 0) *(u32x4*)(DEC + (size_t)row * D + c) = pk8(dec4(cp.x0, a0), dec4(cp.x1, a1));
        else if (j == 1) *(u32x4*)(AA + (size_t)row * D + c) = pk8(sig4(cp.x0, a0), sig4(cp.x1, a1));
        else *(u32x4*)(GG + (size_t)row * D + c) = pk8(a0, a1);
        return 0.f;
    }
};
struct F_S5A {
    static constexpr bool PAIRED = false, NEED_RSTD = false, HAS_SSQ = false;
    typedef NoPre CP; typedef NoPre RP;
    float* HLOC;
    __device__ __forceinline__ CP cpre(int, int) const { return CP{}; }
    __device__ __forceinline__ RP rpre(int, int) const { return RP{}; }
    __device__ __forceinline__ float fin(int row, int col, f32x4 a0, f32x4 a1, f32x4, f32x4, float, const CP&, const RP&) const {
        if (col < 128) { *(f32x4*)(HLOC + (size_t)row * 128 + col) = a0; *(f32x4*)(HLOC + (size_t)row * 128 + col + 4) = a1; } return 0.f; }
};
struct F_S5C {
    static constexpr bool PAIRED = false, NEED_RSTD = false, HAS_SSQ = false;
    typedef X8 CP; typedef U8 RP;
    const bf16_t* A2p; const float* dsk; bf16_t* YBp;
    __device__ __forceinline__ CP cpre(int row0, int col) const { const int ch = (row0 >> 10) * 16 + (col & 15); return CP{*(const f32x4*)(dsk + ch), *(const f32x4*)(dsk + ch + 4)}; }
    __device__ __forceinline__ RP rpre(int row, int col) const { return RP{*(const u32x4*)(A2p + (size_t)row * 384 + col)}; }
    __device__ __forceinline__ float fin(int row, int col, f32x4 a0, f32x4 a1, f32x4, f32x4, float, const CP& cp, const RP& r) const {
        const int g = row >> 10, b = (row >> 7) & 7, j = row & 127, s = col >> 4, c = col & 15, tok = b * LSEQ + j * 16 + s, ch = g * 16 + c;
        UNPK8(r.w, u0, u1); f32x4 o0, o1;
#pragma unroll
        for (int e = 0; e < 4; ++e) { o0[e] = gelu_tanh(a0[e] + cp.x0[e] * u0[e]); o1[e] = gelu_tanh(a1[e] + cp.x1[e] * u1[e]); }
        *(u32x4*)(YBp + (size_t)tok * D + ch) = pk8(o0, o1); return 0.f;
    }
};


template <int CTRL> __device__ __forceinline__ float dpp_mov(float x) { return __builtin_bit_cast(float, __builtin_amdgcn_mov_dpp(__builtin_bit_cast(int, x), CTRL, 0xf, 0xf, true)); }
template <int CTRL> __device__ __forceinline__ float dpp_shr_old(float old, float x) { return __builtin_bit_cast(float, __builtin_amdgcn_update_dpp(__builtin_bit_cast(int, old), __builtin_bit_cast(int, x), CTRL, 0xf, 0xf, false)); }
struct EpiFFN {
    static constexpr bool IDEMP = false;
    bf16_t* ACT; float* HALO; float* GFIX; float* UPFIX; const float* ssq_in; const float* cw; const float* cb; float* fcp; LAS float* xch;
    __device__ __forceinline__ void operator()(f32x4 (&acc)[2][2][4][2], const pg8::Unit& u, int wr, int wc, int fr, int fq) const {
        const int colg = u.pn * 128 + wc * 32 + fq * 8, pm = u.pm;
        const int tix = ((wr * 4 + wc) * 4 + fq) * 16 + fr, twhich = tix >> 7, tcol = tix & 127, rrow = tix >> 1, rh = tix & 1;
        const float* sp = ssq_in + (size_t)(pm * 256 + rrow) * 32 + rh * 16;
        const f32x4 s0 = *(const f32x4*)sp, s1 = *(const f32x4*)(sp + 4), s2 = *(const f32x4*)(sp + 8), s3 = *(const f32x4*)(sp + 12);
        const float tval = twhich < 3 ? cw[(size_t)twhich * FF + u.pn * 128 + tcol] : cb[u.pn * 128 + tcol];
        LAS float* wtab = xch + 1024; LAS float* rtab = xch + 1536;
        { const f32x4 t = (s0 + s1) + (s2 + s3); float sm = (t[0] + t[1]) + (t[2] + t[3]); sm += __shfl_xor(sm, 1); if (rh == 0) rtab[rrow] = rstd_from(sm); }
        wtab[tix] = tval;
        asm volatile("s_waitcnt lgkmcnt(0)" ::: "memory"); __builtin_amdgcn_s_barrier(); asm volatile("" ::: "memory");
#pragma unroll
        for (int ai = 0; ai < 2; ++ai)
#pragma unroll
            for (int m = 0; m < 4; ++m) { const float rs = rtab[ai * 128 + wr * 64 + m * 16 + fr];
#pragma unroll
                for (int n = 0; n < 2; ++n) { acc[ai][0][m][n] *= rs; acc[ai][1][m][n] *= rs; } }
        if (fr >= 14) {
#pragma unroll
            for (int ai = 0; ai < 2; ++ai)
#pragma unroll
                for (int n = 0; n < 2; ++n) *(LAS f32x4*)(xch + (((((ai * 2 + wr) * 4 + wc) * 2 + (fr - 14)) * 4 + fq) * 8 + n * 4)) = acc[ai][0][3][n];
            if (wr == 1) {
#pragma unroll
                for (int n = 0; n < 2; ++n) { *(f32x4*)(HALO + (size_t)(pm * 2 + fr - 14) * FF + colg + 4 * n) = acc[1][0][3][n];
                    if ((pm & 7) == 7) *(f32x4*)(fcp + (size_t)((pm >> 3) * 2 + fr - 14) * FF + colg + 4 * n) = acc[1][0][3][n]; }
            }
        }
        if (wr == 0 && fr < 2) {
#pragma unroll
            for (int n = 0; n < 2; ++n) { *(f32x4*)(GFIX + (size_t)(pm * 2 + fr) * FF + colg + 4 * n) = acc[0][0][0][n]; *(f32x4*)(UPFIX + (size_t)(pm * 2 + fr) * FF + colg + 4 * n) = acc[0][1][0][n]; }
        }
        asm volatile("s_waitcnt lgkmcnt(0)" ::: "memory"); __builtin_amdgcn_s_barrier(); asm volatile("" ::: "memory");
        f32x4 w0[2], w1[2], w2[2], bb[2];
#pragma unroll
        for (int n = 0; n < 2; ++n) { const int lc = wc * 32 + fq * 8 + 4 * n; w0[n] = *(const LAS f32x4*)(wtab + lc); w1[n] = *(const LAS f32x4*)(wtab + 128 + lc); w2[n] = *(const LAS f32x4*)(wtab + 256 + lc); bb[n] = *(const LAS f32x4*)(wtab + 384 + lc); }
#pragma unroll
        for (int ai = 0; ai < 2; ++ai) {
            f32x4 prev[2];
            if (ai == 0 && wr == 0) { prev[0] = (f32x4){0.f, 0.f, 0.f, 0.f}; prev[1] = prev[0]; }
            else { const int sbk = wr == 1 ? ai * 2 : (ai - 1) * 2 + 1;
#pragma unroll
                for (int n = 0; n < 2; ++n) prev[n] = *(const LAS f32x4*)(xch + ((((sbk * 4 + wc) * 2 + (fr & 1)) * 4 + fq) * 8 + n * 4)); }
#pragma unroll
            for (int m = 0; m < 4; ++m) {
                const int row = pm * 256 + ai * 128 + wr * 64 + m * 16 + fr; f32x4 o[2];
#pragma unroll
                for (int n = 0; n < 2; ++n) {
                    const f32x4 gc = acc[ai][0][m][n], gp = m == 0 ? prev[n] : acc[ai][0][m - 1][n], up = acc[ai][1][m][n];
#pragma unroll
                    for (int e = 0; e < 4; ++e) {
                        const float x1 = dpp_shr_old<0x111>(dpp_mov<0x121>(gp[e]), gc[e]), x2 = dpp_shr_old<0x112>(dpp_mov<0x122>(gp[e]), gc[e]);
                        const float c = bb[n][e] + x2 * w0[n][e] + x1 * w1[n][e] + gc[e] * w2[n][e];
                        o[n][e] = c * sigmoidf_(c) * up[e];
                    }
                }
                *(u32x4*)(ACT + (size_t)row * FF + colg) = pk8(o[0], o[1]);
            }
        }
    }
};
struct F_FFNIN_S {
    static constexpr bool PAIRED = true, NEED_RSTD = true, HAS_SSQ = false;
    typedef NoPre CP; typedef NoPre RP;
    bf16_t* ACT; const float* st; float* so; const float* cw; const float* cb;
    __device__ __forceinline__ CP cpre(int, int) const { return CP{}; }
    __device__ __forceinline__ RP rpre(int, int) const { return RP{}; }
    __device__ __forceinline__ float fin(int row, int col, f32x4 a0, f32x4 a1, f32x4 b0, f32x4 b1, float rs, const CP&, const RP&) const {
        const int bs = row - MP; f32x4 o[2];
#pragma unroll
        for (int n = 0; n < 2; ++n) { const int c = col + 4 * n; const f32x4 g = (n ? a1 : a0) * rs, up = (n ? b1 : b0) * rs;
            const f32x4 x0 = *(const f32x4*)(st + (size_t)(bs * 2) * FF + c), x1 = *(const f32x4*)(st + (size_t)(bs * 2 + 1) * FF + c);
            *(f32x4*)(so + (size_t)(bs * 2) * FF + c) = x1; *(f32x4*)(so + (size_t)(bs * 2 + 1) * FF + c) = g;
            const f32x4 cv = *(const f32x4*)(cb + c) + x0 * *(const f32x4*)(cw + c) + x1 * *(const f32x4*)(cw + FF + c) + g * *(const f32x4*)(cw + 2 * FF + c);
#pragma unroll
            for (int e = 0; e < 4; ++e) o[n][e] = cv[e] * sigmoidf_(cv[e]) * up[e]; }
        *(u32x4*)(ACT + (size_t)row * FF + col) = pk8(o[0], o[1]); return 0.f;
    }
};

struct F_NULL1 { static constexpr bool PAIRED = false, NEED_RSTD = false, HAS_SSQ = false; typedef NoPre CP; typedef NoPre RP; float* sink;
    __device__ __forceinline__ CP cpre(int, int) const { return CP{}; }
    __device__ __forceinline__ RP rpre(int, int) const { return RP{}; }
    __device__ __forceinline__ float fin(int row, int col, f32x4 v0, f32x4 v1, f32x4, f32x4, float, const CP&, const RP&) const { if (v0[0] == 12345.678f) sink[0] = v0[1] + v0[2] + v0[3] + v1[0]; return 0.f; } };
struct F_NULL2 { static constexpr bool PAIRED = true, NEED_RSTD = false, HAS_SSQ = false; typedef NoPre CP; typedef NoPre RP; float* sink;
    __device__ __forceinline__ CP cpre(int, int) const { return CP{}; }
    __device__ __forceinline__ RP rpre(int, int) const { return RP{}; }
    __device__ __forceinline__ float fin(int row, int col, f32x4 v0, f32x4 v1, f32x4 w0, f32x4 w1, float, const CP&, const RP&) const { if (v0[0] == 12345.678f) sink[0] = v0[1] + v1[2] + w0[3] + w1[0]; return 0.f; } };
template <class F>
__device__ __forceinline__ void sample_gemm_(LAS unsigned char* lds, const bf16_t* A, int lda, const bf16_t* Bt, int ldb, int ncb, int K, int row_base,
                                            const F& f, const float* ssq_in, float* ssq_out, int a_cb_div, int a_cb_stride, int wg0) {
    const int tid = otid(), wid = tid >> 6, lane = tid & 63, r32 = lane & 31, kq = lane >> 5;
    LAS float* red = (LAS float*)lds;
    const int ks = K / 16, k0 = wid * ks / 8, k1 = (wid + 1) * ks / 8;
    const int nwg_ = (int)gridDim.x - wg0;
    for (int tile = obid() - wg0; tile >= 0 && tile < 4 * ncb; tile += nwg_) {
        const int rb = tile & 3, cb = tile >> 2;
        const int brow0 = F::PAIRED ? ((cb >> 2) * 256 + (cb & 3) * 32) : cb * 32;
        const bf16_t* ap = A + (size_t)(rb * 32 + r32) * lda + kq * 8 + (cb / a_cb_div) * a_cb_stride;
        const bf16_t* bp = Bt + (size_t)(brow0 + r32) * ldb + kq * 8;
        f32x16 acc0, acc1;
#pragma unroll
        for (int i = 0; i < 16; ++i) { acc0[i] = 0.f; acc1[i] = 0.f; }
        constexpr int NBT = F::PAIRED ? 8 : 11;
        for (int k = k0; k < k1; k += NBT) {
            bf16x8 av[NBT], bv[NBT], cv[NBT];
#pragma unroll
            for (int i = 0; i < NBT; ++i) if (k + i < k1) { av[i] = *(const bf16x8*)(ap + (k + i) * 16); bv[i] = *(const bf16x8*)(bp + (k + i) * 16); if (F::PAIRED) cv[i] = *(const bf16x8*)(bp + (size_t)128 * ldb + (k + i) * 16); }
#pragma unroll
            for (int i = 0; i < NBT; ++i) if (k + i < k1) { acc0 = __builtin_amdgcn_mfma_f32_32x32x16_bf16(av[i], bv[i], acc0, 0, 0, 0); if (F::PAIRED) acc1 = __builtin_amdgcn_mfma_f32_32x32x16_bf16(av[i], cv[i], acc1, 0, 0, 0); }
        }
#pragma unroll
        for (int r = 0; r < 16; ++r) { const int rw = (r & 3) + 8 * (r >> 2) + 4 * kq;
            red[(wid * 32 + rw) * 33 + r32] = acc0[r]; if (F::PAIRED) red[8448 + (wid * 32 + rw) * 33 + r32] = acc1[r]; }
        __syncthreads();
        if (tid < 128) {
            const int row = tid >> 2, c8 = (tid & 3) * 8, grow = row_base + rb * 32 + row;
            f32x4 v0 = {0.f, 0.f, 0.f, 0.f}, v1 = v0, w0 = v0, w1 = v0;
#pragma unroll
            for (int w = 0; w < 8; ++w)
#pragma unroll
                for (int e = 0; e < 4; ++e) { v0[e] += red[(w * 32 + row) * 33 + c8 + e]; v1[e] += red[(w * 32 + row) * 33 + c8 + 4 + e];
                    if (F::PAIRED) { w0[e] += red[8448 + (w * 32 + row) * 33 + c8 + e]; w1[e] += red[8448 + (w * 32 + row) * 33 + c8 + 4 + e]; } }
            float rs = 1.f;
            if (F::NEED_RSTD) { const f32x4 a = *(const f32x4*)(ssq_in + (size_t)grow * 32 + (tid & 3) * 8), b = *(const f32x4*)(ssq_in + (size_t)grow * 32 + (tid & 3) * 8 + 4);
                float s = (a[0] + a[1]) + (a[2] + a[3]) + (b[0] + b[1]) + (b[2] + b[3]); s += __shfl_xor(s, 1); s += __shfl_xor(s, 2); rs = rstd_from(s); }
            const typename F::CP cp_ = f.cpre(grow, cb * 32 + c8); const typename F::RP rp_ = f.rpre(grow, cb * 32 + c8);
            float q = f.fin(grow, cb * 32 + c8, v0, v1, w0, w1, rs, cp_, rp_);
            if (F::HAS_SSQ) { q += __shfl_xor(q, 1); q += __shfl_xor(q, 2); if ((tid & 3) == 0) ssq_out[(size_t)grow * 32 + cb] = q; }
        }
        __syncthreads();
    }
}

template <class F>
__device__ __forceinline__ void sample_gemm(LAS unsigned char* lds, const bf16_t* A, int lda, const bf16_t* Bt, int ldb, int ncb, int K, int row_base,
                                            const F& f, const float* ssq_in, float* ssq_out, int a_cb_div = 1 << 30, int a_cb_stride = 0, int wg0 = 0) {
    if (wg0 >= (int)gridDim.x) wg0 = 0;
    if (PROBE_SG2) { if (F::PAIRED) { F_NULL2 n{ssq_out ? ssq_out : (float*)ssq_in}; sample_gemm_(lds, A, lda, Bt, ldb, ncb, K, row_base, n, nullptr, nullptr, a_cb_div, a_cb_stride, wg0); }
                     else { F_NULL1 n{ssq_out ? ssq_out : (float*)ssq_in}; sample_gemm_(lds, A, lda, Bt, ldb, ncb, K, row_base, n, nullptr, nullptr, a_cb_div, a_cb_stride, wg0); } }
    sample_gemm_(lds, A, lda, Bt, ldb, ncb, K, row_base, f, ssq_in, ssq_out, a_cb_div, a_cb_stride, wg0);
}
struct Args { const float* in[50]; float* out; unsigned char* ws; int lo, hi; };
enum { I_XP = 0, I_XS, I_S5RE, I_S5IM, I_WKV, I_SHIFT, I_LH, I_LC, I_FC, I_NMIX, I_NFFN, I_NFIN, I_S5ARE, I_S5AIM, I_S5LDT, I_S5BRE, I_S5BIM, I_S5CRE, I_S5CIM,
       I_S5D, I_S5GLU, I_RWMU, I_RWRKV, I_RWW0, I_RWW1, I_RWW2, I_RWA0, I_RWA1, I_RWA2, I_RWG1, I_RWG2, I_RWKK, I_RWKA, I_RWRK, I_RWLNW, I_RWLNB, I_RWWO,
       I_LWIN, I_LCW, I_LCB, I_LWRG, I_LBRG, I_LWIG, I_LBIG, I_LLAM, I_LWOUT, I_FWIN, I_FCW, I_FCB, I_FWOUT };
typedef const __attribute__((address_space(4))) Args& ArgsR;
typedef const __attribute__((address_space(4))) Args* ArgsP;
__device__ __forceinline__ ArgsP opaque_args() { ArgsP p = (ArgsP)__builtin_amdgcn_kernarg_segment_ptr(); asm volatile("" : "+s"(p)); return p; }
#define WSB(off) ((bf16_t*)(a.ws + (off)))
#define WSF(off) ((float*)(a.ws + (off)))
#define NTHR 512

__device__ __forceinline__ void tr_item(const float* W, int ldw, const float* ks, bf16_t* dst, int dst_ld, int k0, int n0, int drow0, int dk0, LAS float* scr, int lane) {
    float v[32];
    const float* wp = W + (size_t)(k0 + (lane >> 5)) * ldw + n0 + (lane & 31);
#pragma unroll
    for (int i = 0; i < 32; ++i) v[i] = wp[(size_t)(2 * i) * ldw];
    if (ks) {
#pragma unroll
        for (int i = 0; i < 32; ++i) v[i] *= ks[k0 + 2 * i + (lane >> 5)];
    }
#pragma unroll
    for (int i = 0; i < 32; ++i) scr[(2 * i + (lane >> 5)) * 33 + (lane & 31)] = v[i];
    asm volatile("s_waitcnt lgkmcnt(0)" ::: "memory");
    const int c = lane & 7;
#pragma unroll
    for (int j = 0; j < 4; ++j) { const int n = (lane >> 3) + 8 * j; const LAS float* s = scr + (8 * c) * 33 + n;
        u32x4 o; o.x = pk2(s[0 * 33], s[1 * 33]); o.y = pk2(s[2 * 33], s[3 * 33]); o.z = pk2(s[4 * 33], s[5 * 33]); o.w = pk2(s[6 * 33], s[7 * 33]);
        *(u32x4*)(dst + (size_t)(drow0 + n) * dst_ld + dk0 + k0 + 8 * c) = o; }
    asm volatile("s_waitcnt lgkmcnt(0)" ::: "memory");
}

__device__ __forceinline__ void convert_items(ArgsR a, LAS unsigned char* lds, int gw, int NGW, int which) {
    const int tid = otid(), lane = tid & 63, wave = tid >> 6;
    LAS float* scr = (LAS float*)(lds + wave * 16384);
    const int total = which == 0 ? 14336 : 10240;
#pragma nounroll
    for (int q = gw; q < total; q += NGW) {
        int fit;
        if (which == 0) fit = q < 7680 ? q : (q < 10496 ? 13312 + (q - 7680) : 18944 + (q - 10496));
        else fit = q < 5632 ? 7680 + q : (q < 8448 ? 16128 + (q - 5632) : 22784 + (q - 8448));
        int job, it;
        if (fit < 2048) { job = fit >> 10; it = fit & 1023; }
        else if (fit < 13312) { const int q = fit - 2048; job = 2 + q / 2816; it = q % 2816; }
        else if (fit < 18944) { const int q = fit - 13312; job = 6 + q / 1408; it = q % 1408; }
        else if (fit < 22016) { const int q = fit - 18944; job = 10 + (q >> 9); it = q & 511; }
        else if (fit < 22272) { const int q = fit - 22016; if (q < 128) { job = 16 + (q >> 5); it = q & 31; } else { job = 20 + ((q - 128) >> 6); it = (q - 128) & 63; } }
        else if (fit < 22784) { job = 22; it = fit - 22272; }
        else if (fit < 23808) { job = 23; it = fit - 22784; }
        else if (fit < 24064) { const int q = fit - 23808; job = 24 + (q >> 5); it = q & 31; }
        else { job = 32; it = fit - 24064; }
        const float* src; const float* ks = nullptr; bf16_t* dst; int ldw, K, N, dst_ld, dk0 = 0, H = 0, row_off = 0;
        if (job < 2) { src = a.in[I_S5GLU] + (size_t)job * 1024 * 2048; ldw = 2048; K = 1024; N = 2048; dst = WSB(WS_WGLU) + (size_t)job * 2048 * 1024; dst_ld = 1024; H = 1024; }
        else if (job < 6) { const int i = job - 2; src = a.in[I_FWIN] + (size_t)i * 1024 * 5632; ldw = 5632; K = 1024; N = 5632; ks = a.in[I_NFFN] + i * 1024; dst = WSB(WS_WFIN) + (size_t)i * 5632 * 1024; dst_ld = 1024; H = 2816; }
        else if (job < 10) { const int i = job - 6; src = a.in[I_FWOUT] + (size_t)i * 2816 * 1024; ldw = 1024; K = 2816; N = 1024; dst = WSB(WS_WFOUT) + (size_t)i * 1024 * 2816; dst_ld = 2816; }
        else if (job < 16) { const int q = job - 10, j = q >> 1, hf = q & 1; src = a.in[I_RWRKV] + (size_t)j * 1024 * 1024; ldw = 1024; K = 1024; N = 1024; if (hf) ks = a.in[I_RWMU] + j * 1024;
            dst = WSB(WS_WRW2); dst_ld = 2048; dk0 = hf * 1024; row_off = j * 1024; }
        else if (job < 22) { const int q = job - 16, m = q >> 1, hf = q & 1; src = m == 0 ? a.in[I_RWW1] : (m == 1 ? a.in[I_RWA1] : a.in[I_RWG1]); N = m == 2 ? 128 : 64; ldw = N; K = 1024;
            if (hf) ks = a.in[I_RWMU] + (3 + m) * 1024; dst = WSB(WS_WRW2); dst_ld = 2048; dk0 = hf * 1024; row_off = 3072 + m * 64; }
        else if (job == 22) { src = a.in[I_RWWO]; ldw = 1024; K = 1024; N = 1024; dst = WSB(WS_WRWO); dst_ld = 1024; }
        else if (job == 23) { src = a.in[I_LWIN]; ldw = 2048; K = 1024; N = 2048; ks = a.in[I_NMIX] + 2 * 1024; dst = WSB(WS_WLIN); dst_ld = 1024; H = 1024; }
        else if (job < 32) { const int q = job - 24, kind = q >> 2, nb = q & 3; src = (kind ? a.in[I_LWIG] : a.in[I_LWRG]) + (size_t)nb * 65536; ldw = 256; K = 256; N = 256;
            dst = WSB(WS_WRGIG); dst_ld = 256; H = 256; row_off = nb * 512 + kind * 128; }
        else { src = a.in[I_LWOUT]; ldw = 1024; K = 1024; N = 1024; dst = WSB(WS_WLOUT); dst_ld = 1024; }
        (void)K;
        const int nblk = N / 32;
        {
            const int kb = it / nblk, nbk = it % nblk, n0 = nbk * 32;
            int drow0;
            if (H) { const int nr = n0 % H, kind = n0 / H; drow0 = row_off + (nr >> 7) * 256 + kind * 128 + (nr & 127); } else drow0 = row_off + n0;
            tr_item(src, ldw, ks, dst, dst_ld, kb * 64, n0, drow0, dk0, scr, lane);
        }
    }
}
__device__ __forceinline__ void prologue_weights(ArgsR a, LAS unsigned char* lds) {
    const int tid = otid(), lane = tid & 63, wave = tid >> 6;
    const int gw = obid() * 8 + wave, NGW = gridDim.x * 8;
    convert_items(a, lds, gw, NGW, 0);
    const int gt = obid() * NTHR + tid, NGT = gridDim.x * NTHR;
    for (int it = gt; it < 3072 * 32; it += NGT) {
        const int n = it >> 5, k8 = (it & 31) * 8, j = n >> 10, c = n & 1023; float v[8];
#pragma unroll
        for (int e = 0; e < 8; ++e) { const int k = k8 + e; float x = 0.f;
            if (j == 0) { if (k < 64) x = a.in[I_RWW2][(size_t)k * 1024 + c]; }
            else if (j == 1) { if (k >= 64 && k < 128) x = a.in[I_RWA2][(size_t)(k - 64) * 1024 + c]; }
            else { if (k >= 128) x = a.in[I_RWG2][(size_t)(k - 128) * 1024 + c]; }
            v[e] = x; }
        u32x4 o; o.x = pk2(v[0], v[1]); o.y = pk2(v[2], v[3]); o.z = pk2(v[4], v[5]); o.w = pk2(v[6], v[7]);
        *(u32x4*)(WSB(WS_WRW3) + (size_t)n * 256 + k8) = o;
    }
    for (int c = gt; c < 1024; c += NGT) { const float lam = a.in[I_LLAM][c]; WSF(WS_LSL)[c] = -8.f * log1pf(__expf(-lam)); }
    for (int row0 = gw; row0 < MA; row0 += 4 * NGW) {
        f32x4 xv[4][4]; int rws[4];
#pragma unroll
        for (int u = 0; u < 4; ++u) { const int row = row0 + u * NGW < MA ? row0 + u * NGW : row0; rws[u] = row;
            const float* xr = row < MP ? a.in[I_XP] + (size_t)row * D : a.in[I_XS] + (size_t)(row - MP) * D;
#pragma unroll
            for (int q = 0; q < 4; ++q) xv[u][q] = *(const f32x4*)(xr + lane * 4 + 256 * q); }
        float sv[4];
#pragma unroll
        for (int u = 0; u < 4; ++u) { float t = 0.f;
#pragma unroll
            for (int q = 0; q < 4; ++q) { const f32x4 v = xv[u][q]; t += (v[0] * v[0] + v[1] * v[1]) + (v[2] * v[2] + v[3] * v[3]); }
            sv[u] = t; }
#pragma unroll
        for (int o = 1; o < 64; o <<= 1) {
#pragma unroll
            for (int u = 0; u < 4; ++u) sv[u] += __shfl_xor(sv[u], o); }
#pragma unroll
        for (int u = 0; u < 4; ++u) if (lane < 32 && (u == 0 || row0 + u * NGW < MA)) WSF(WS_SSQ)[(size_t)rws[u] * 32 + lane] = lane == 0 ? sv[u] : 0.f;
    }
}

__device__ const double s5_kc[12] = {1.0 / 24, 1.0 / 720, 1.0 / 40320, 1.0 / 3628800, 1.0 / 479001600, 1.0 / 6, 1.0 / 120, 1.0 / 5040, 1.0 / 362880, 1.0 / 39916800, 1.0 / 6227020800.0, 0.0};
__device__ __forceinline__ void s5_gen(ArgsR a, LAS unsigned char* lds, int j) {
    const int tid = otid();
    LAS float* abp = (LAS float*)lds;
    LAS float* cB = abp + 17 * 128;
    LAS float* Cc = cB + 2048;
    LAS float* Kt = Cc + 2048;
    for (int g4 = obid(); g4 < 256; g4 += gridDim.x) {
        const int g = g4 >> 2, part = g4 & 3;
        __syncthreads();
        if (tid < 64) {
            const int p = tid, idx = (j * 64 + g) * 64 + p;
            const double lr = (double)fminf(a.in[I_S5ARE][idx], -1e-4f), li = (double)a.in[I_S5AIM][idx], dt = exp((double)a.in[I_S5LDT][j * 64 + g]);
            const double mag = exp(lr * dt); double ang = li * dt * 0.15915494309189535; ang -= rint(ang); const double th = ang * 6.283185307179586 * 0.125;
            const double t2 = th * th;
            const double* kc = s5_kc; asm volatile("" : "+s"(kc));
            double cs = 1.0 - t2 * (0.5 - t2 * (kc[0] - t2 * (kc[1] - t2 * (kc[2] - t2 * (kc[3] - t2 * kc[4])))));
            double sn = th * (1.0 - t2 * (kc[5] - t2 * (kc[6] - t2 * (kc[7] - t2 * (kc[8] - t2 * (kc[9] - t2 * kc[10]))))));
#pragma unroll
            for (int r = 0; r < 3; ++r) { const double c2 = cs * cs - sn * sn, s2 = 2.0 * cs * sn; cs = c2; sn = s2; }
            const double abr = mag * cs, abi = mag * sn, den = lr * lr + li * li;
            const double cr = ((abr - 1.0) * lr + abi * li) / den, ci = (abi * lr - (abr - 1.0) * li) / den;
            double pr = 1.0, pi = 0.0;
#pragma unroll 1
            for (int t = 0; t <= 16; ++t) { abp[(t * 64 + p) * 2] = (float)pr; abp[(t * 64 + p) * 2 + 1] = (float)pi; const double nr = pr * abr - pi * abi, ni = pr * abi + pi * abr; if (t < 16) { pr = nr; pi = ni; } }
            float* tb = WSF(WS_TBL) + (size_t)idx * 8;
            if (part == 0) { tb[0] = (float)abr; tb[1] = (float)abi; tb[2] = (float)cr; tb[3] = (float)ci; tb[4] = (float)pr; tb[5] = (float)pi; tb[6] = 0.f; tb[7] = 0.f; }
            const float crf = (float)cr, cif = (float)ci;
#pragma unroll 4
            for (int c = 0; c < 16; ++c) { const float br = a.in[I_S5BRE][(size_t)idx * 16 + c], bi = a.in[I_S5BIM][(size_t)idx * 16 + c];
                cB[(p * 16 + c) * 2] = crf * br - cif * bi; cB[(p * 16 + c) * 2 + 1] = crf * bi + cif * br; }
        }
        for (int e = tid; e < 1024; e += NTHR) { const size_t si = (size_t)(j * 64 + g) * 1024 + e; Cc[e * 2] = a.in[I_S5CRE][si]; Cc[e * 2 + 1] = a.in[I_S5CIM][si]; }
        __syncthreads();
        if (tid < 256) {
            const int tau = tid >> 4, c1 = tid & 15; float acc[16];
#pragma unroll
            for (int c = 0; c < 16; ++c) acc[c] = 0.f;
#pragma unroll 2
            for (int p = 0; p < 64; ++p) {
                const float ar = abp[(tau * 64 + p) * 2], ai = abp[(tau * 64 + p) * 2 + 1], br = cB[(p * 16 + c1) * 2], bi = cB[(p * 16 + c1) * 2 + 1];
                const float wr = ar * br - ai * bi, wi = ar * bi + ai * br;
#pragma unroll
                for (int c = 0; c < 16; ++c) acc[c] += Cc[(c * 64 + p) * 2] * wr - Cc[(c * 64 + p) * 2 + 1] * wi;
            }
#pragma unroll
            for (int c = 0; c < 16; ++c) Kt[(tau * 16 + c) * 16 + c1] = acc[c];
        }
        __syncthreads();
        bf16_t* BC = WSB(WS_AR + AR_S5C) + (size_t)g * 256 * 384;
        for (int e = part * 64 * 192 + tid; e < (part + 1) * 64 * 192; e += NTHR) {
            const int n = e / 192, k2 = (e % 192) * 2, s = n >> 4, c = n & 15; float v[2];
#pragma unroll
            for (int hh = 0; hh < 2; ++hh) { const int k = k2 + hh;
                if (k < 256) { const int s1 = k >> 4, c1 = k & 15; v[hh] = s >= s1 ? Kt[((s - s1) * 16 + c) * 16 + c1] : 0.f; }
                else { const int p = (k - 256) >> 1, part = (k - 256) & 1; const float cr = Cc[(c * 64 + p) * 2], ci = Cc[(c * 64 + p) * 2 + 1], ar = abp[((s + 1) * 64 + p) * 2], ai = abp[((s + 1) * 64 + p) * 2 + 1];
                    v[hh] = part == 0 ? (cr * ar - ci * ai) : -(cr * ai + ci * ar); } }
            *(unsigned*)(BC + (size_t)n * 384 + k2) = pk2(v[0], v[1]);
        }
        bf16_t* BA = WSB(WS_AR + AR_S5A) + (size_t)g * 256 * 256;
        for (int e = part * 64 * 128 + tid; e < (part + 1) * 64 * 128; e += NTHR) {
            const int n = e >> 7, k2 = (e & 127) * 2; float v[2] = {0.f, 0.f};
            if (n < 128) { const int p = n >> 1, part = n & 1;
#pragma unroll
                for (int hh = 0; hh < 2; ++hh) { const int k = k2 + hh, s1 = k >> 4, c1 = k & 15; const float ar = abp[((15 - s1) * 64 + p) * 2], ai = abp[((15 - s1) * 64 + p) * 2 + 1], br = cB[(p * 16 + c1) * 2], bi = cB[(p * 16 + c1) * 2 + 1];
                    v[hh] = part == 0 ? (ar * br - ai * bi) : (ar * bi + ai * br); } }
            *(unsigned*)(BA + (size_t)n * 256 + k2) = pk2(v[0], v[1]);
        }
    }
    __syncthreads();
}

__device__ __forceinline__ void s5_u_phase(ArgsR a, int li, int j) {
    const int tid = otid(), lane = tid & 63, wave = tid >> 6, gw = obid() * 8 + wave, NGW = gridDim.x * 8;
    const float* X = li == 0 ? a.in[I_XP] : a.out; const float* SSQ = WSF(WS_SSQ); const float* gm = a.in[I_NMIX] + li * 1024; bf16_t* A2 = WSB(WS_AR + AR_A2);
    for (int it = gw; it < 4096; it += NGW) {
        const int qd = it & 3, jj = (it >> 2) & 127, b = it >> 9, t0 = b * LSEQ + jj * 16;
        float rs = 0.f;
        { const int s = lane & 15; const float* sp = SSQ + (size_t)(t0 + s) * 32; float q = 0.f;
#pragma unroll
          for (int e = 0; e < 8; ++e) { const f32x4 v = *(const f32x4*)(sp + e * 4); q += (v[0] + v[1]) + (v[2] + v[3]); }
          rs = rstd_from(q); }
        const int s = (lane >> 1) & 15, hf = lane & 1; const float rss = __shfl(rs, s);
        f32x4 xa[8], xb[8];
#pragma unroll
        for (int i = 0; i < 8; ++i) { const int g = (qd * 8 + i) * 2 + (lane >> 5), ch0 = g * 16 + hf * 8; xa[i] = *(const f32x4*)(X + (size_t)(t0 + s) * D + ch0); xb[i] = *(const f32x4*)(X + (size_t)(t0 + s) * D + ch0 + 4); }
#pragma unroll
        for (int i = 0; i < 8; ++i) {
            const int g = (qd * 8 + i) * 2 + (lane >> 5), ch0 = g * 16 + hf * 8;
            const f32x4 g0 = *(const f32x4*)(gm + ch0), g1 = *(const f32x4*)(gm + ch0 + 4);
            const f32x4 u0 = xa[i] * g0 * rss, u1 = xb[i] * g1 * rss; const u32x2 p0 = pk4(u0), p1 = pk4(u1);
            *(u32x4*)(A2 + (size_t)(g * 1024 + b * 128 + jj) * 384 + s * 16 + hf * 8) = (u32x4){p0.x, p0.y, p1.x, p1.y};
        }
    }
    const float* TBL = WSF(WS_TBL); bf16_t* YB = WSB(WS_AR + AR_YB);
    for (int it = gw; it < 128 * 64; it += NGW) {
        const int g = it & 63, bs = it >> 6, row = MP + bs, p = lane;
        float q = lane < 32 ? SSQ[(size_t)row * 32 + lane] : 0.f; q = wave_sum(q); const float rs = rstd_from(q);
        const int cc = lane & 15; const float* xsr = li == 0 ? a.in[I_XS] + (size_t)bs * D : a.out + (size_t)row * D; const float uc = xsr[g * 16 + cc] * rs * gm[g * 16 + cc];
        const size_t pi = (size_t)((j * 64 + g) * 64 + p);
        float bur = 0.f, bui = 0.f;
#pragma unroll
        for (int c = 0; c < 16; ++c) { const float u = __shfl(uc, c); bur += a.in[I_S5BRE][pi * 16 + c] * u; bui += a.in[I_S5BIM][pi * 16 + c] * u; }
        const float* tb = TBL + pi * 8; const float abr = tb[0], abi = tb[1], cr = tb[2], ci = tb[3];
        const size_t si = (size_t)(j * 128 + bs) * 4096 + g * 64 + p;
        const float h0r = a.in[I_S5RE][si], h0i = a.in[I_S5IM][si];
        const float hr = abr * h0r - abi * h0i + (cr * bur - ci * bui), hi = abr * h0i + abi * h0r + (cr * bui + ci * bur);
        a.out[O_S5RE_S + si] = hr; a.out[O_S5IM_S + si] = hi;
        float yv = 0.f; float tsum[16];
#pragma unroll
        for (int c = 0; c < 16; ++c) { const size_t ci2 = (size_t)((j * 64 + g) * 16 + c) * 64 + p; tsum[c] = a.in[I_S5CRE][ci2] * hr - a.in[I_S5CIM][ci2] * hi; }
#pragma unroll
        for (int o = 1; o < 64; o <<= 1) {
#pragma unroll
            for (int c = 0; c < 16; ++c) tsum[c] += __shfl_xor(tsum[c], o); }
#pragma unroll
        for (int c = 0; c < 16; ++c) if (cc == c) yv = tsum[c];
        if (lane < 16) { const float y = yv + a.in[I_S5D][j * 1024 + g * 16 + cc] * uc; YB[(size_t)row * D + g * 16 + cc] = (bf16_t)f2bf(gelu_tanh(y)); }
    }
}
__device__ __forceinline__ void s5_carry_phase(ArgsR a, int j) {
    const int gt = obid() * NTHR + otid(), NGT = gridDim.x * NTHR, lane = otid() & 63, lb = lane & ~3;
    const float* TBL = WSF(WS_TBL); const float* HL = WSF(WS_AR + AR_HLOC); bf16_t* A2 = WSB(WS_AR + AR_A2);
    for (int id = gt; id < 131072; id += NGT) {
        const int sg = id & 3, p = (id >> 2) & 63, g = (id >> 8) & 63, b = id >> 14; const float* tb = TBL + (size_t)((j * 64 + g) * 64 + p) * 8; const float ar = tb[4], ai = tb[5];
        const size_t row0 = (size_t)g * 1024 + b * 128 + sg * 32;
        float er = 0.f, ei = 0.f;
#pragma unroll 16
        for (int k = 0; k < 32; ++k) { const f32x2 hl = *(const f32x2*)(HL + (row0 + k) * 128 + 2 * p); const float nr = ar * er - ai * ei + hl.x, ni = ar * ei + ai * er + hl.y; er = nr; ei = ni; }
        float pr = ar, pi = ai;
#pragma unroll
        for (int q = 0; q < 5; ++q) { const float nr = pr * pr - pi * pi, ni = 2.f * pr * pi; pr = nr; pi = ni; }
        const float e0r = __shfl(er, lb), e0i = __shfl(ei, lb), e1r = __shfl(er, lb + 1), e1i = __shfl(ei, lb + 1), e2r = __shfl(er, lb + 2), e2i = __shfl(ei, lb + 2);
        const float h1r = e0r, h1i = e0i;
        const float h2r = pr * h1r - pi * h1i + e1r, h2i = pr * h1i + pi * h1r + e1i;
        const float h3r = pr * h2r - pi * h2i + e2r, h3i = pr * h2i + pi * h2r + e2i;
        float hr = sg == 0 ? 0.f : (sg == 1 ? h1r : (sg == 2 ? h2r : h3r)), hi = sg == 0 ? 0.f : (sg == 1 ? h1i : (sg == 2 ? h2i : h3i));
#pragma unroll 1
        for (int k0 = 0; k0 < 32; k0 += 16) { f32x2 hl[16];
#pragma unroll
            for (int k = 0; k < 16; ++k) hl[k] = *(const f32x2*)(HL + (row0 + k0 + k) * 128 + 2 * p);
#pragma unroll
            for (int k = 0; k < 16; ++k) { *(unsigned*)(A2 + (row0 + k0 + k) * 384 + 256 + 2 * p) = pk2(hr, hi);
                const float nr = ar * hr - ai * hi + hl[k].x, ni = ar * hi + ai * hr + hl[k].y; hr = nr; hi = ni; } }
        if (sg == 3) { const size_t so = (size_t)(j * 8 + b) * 4096 + g * 64 + p; a.out[O_S5RE_P + so] = hr; a.out[O_S5IM_P + so] = hi; }
    }
}

__device__ __forceinline__ void unpk8(u32x4 w, float* x) { x[0] = bflo(w.x); x[1] = bfhi(w.x); x[2] = bflo(w.y); x[3] = bfhi(w.y); x[4] = bflo(w.z); x[5] = bfhi(w.z); x[6] = bflo(w.w); x[7] = bfhi(w.w); }
__device__ __forceinline__ void ffn_conv_phase(ArgsR a, int li, bool st = true) {
    const int gt = obid() * NTHR + otid(), NGT = gridDim.x * NTHR;
    const bf16_t* G = WSB(WS_AR + AR_G); bf16_t* UP = WSB(WS_AR + AR_UP);
    const float* cw = a.in[I_FCW] + (size_t)li * 3 * FF; const float* cb = a.in[I_FCB] + (size_t)li * FF;
    for (int it = gt; it < (MP / 4) * (FF / 8); it += NGT) {
        const int rq = it / (FF / 8), f = (it % (FF / 8)) * 8, row0 = rq * 4, l0 = row0 & (LSEQ - 1);
        u32x4 g[6], uw[4];
        const u32x4 z = {0, 0, 0, 0};
        g[0] = l0 ? *(const u32x4*)(G + (size_t)(row0 - 2) * FF + f) : z; g[1] = l0 ? *(const u32x4*)(G + (size_t)(row0 - 1) * FF + f) : z;
#pragma unroll
        for (int r = 0; r < 4; ++r) { g[2 + r] = *(const u32x4*)(G + (size_t)(row0 + r) * FF + f); uw[r] = *(const u32x4*)(UP + (size_t)(row0 + r) * FF + f); }
        float w0[8], w1[8], w2[8], bb[8];
#pragma unroll
        for (int e = 0; e < 8; ++e) { w0[e] = cw[f + e]; w1[e] = cw[FF + f + e]; w2[e] = cw[2 * FF + f + e]; bb[e] = cb[f + e]; }
        float x[6][8];
#pragma unroll
        for (int r = 0; r < 6; ++r) unpk8(g[r], x[r]);
#pragma unroll
        for (int r = 0; r < 4; ++r) {
            float up[8], o[8]; unpk8(uw[r], up);
#pragma unroll
            for (int e = 0; e < 8; ++e) { const float c = bb[e] + x[r][e] * w0[e] + x[r + 1][e] * w1[e] + x[r + 2][e] * w2[e]; o[e] = c * sigmoidf_(c) * up[e]; }
            u32x4 ov; ov.x = pk2(o[0], o[1]); ov.y = pk2(o[2], o[3]); ov.z = pk2(o[4], o[5]); ov.w = pk2(o[6], o[7]);
            if (st) *(u32x4*)(UP + (size_t)(row0 + r) * FF + f) = ov;
        }
        if (st && l0 == LSEQ - 4) { float* o = a.out + O_FC_P + ((size_t)(li * 8 + (row0 >> 11)) * 2) * FF + f;
#pragma unroll
            for (int e = 0; e < 8; ++e) { o[e] = x[4][e]; o[FF + e] = x[5][e]; } }
    }
    if (st)
    for (int it = gt; it < MS * (FF / 8); it += NGT) {
        const int bs = it / (FF / 8), f = (it % (FF / 8)) * 8, row = MP + bs;
        float x0[8], x1[8], x2[8], up[8], r[8];
        unpk8(*(const u32x4*)(G + (size_t)row * FF + f), x2); unpk8(*(const u32x4*)(UP + (size_t)row * FF + f), up);
        const float* st = a.in[I_FC] + ((size_t)(li * 128 + bs) * 2) * FF + f; float* o = a.out + O_FC_S + ((size_t)(li * 128 + bs) * 2) * FF + f;
#pragma unroll
        for (int e = 0; e < 8; ++e) { x0[e] = st[e]; x1[e] = st[FF + e]; }
#pragma unroll
        for (int e = 0; e < 8; ++e) { o[e] = x1[e]; o[FF + e] = x2[e]; const float c = cb[f + e] + x0[e] * cw[f + e] + x1[e] * cw[FF + f + e] + x2[e] * cw[2 * FF + f + e]; r[e] = c * sigmoidf_(c) * up[e]; }
        u32x4 ov; ov.x = pk2(r[0], r[1]); ov.y = pk2(r[2], r[3]); ov.z = pk2(r[4], r[5]); ov.w = pk2(r[6], r[7]);
        *(u32x4*)(UP + (size_t)row * FF + f) = ov;
    }
}

__device__ __forceinline__ void rw1_phase(ArgsR a, int li) {
    const int tid = otid(), lane = tid & 63, wave = tid >> 6, gw = obid() * 8 + wave, NGW = gridDim.x * 8;
    const float* X = a.out; const float* SSQ = WSF(WS_SSQ); const float* gm = a.in[I_NMIX] + li * 1024; bf16_t* HX = WSB(WS_AR + AR_HX);
    for (int row = gw; row < MA; row += NGW) {
        const bool prm = row < MP; const int l = row & (LSEQ - 1); const bool hasprev = prm && l > 0;
        float q = 0.f;
        if (lane < 32) q = SSQ[(size_t)row * 32 + lane]; else if (hasprev) q = SSQ[(size_t)(row - 1) * 32 + lane - 32];
        f32x4 xv[4], pv[4], g4[4];
        const float* prow = hasprev ? X + (size_t)(row - 1) * D : (prm ? X + (size_t)row * D : a.in[I_SHIFT] + (size_t)(row - MP) * D);
#pragma unroll
        for (int qq = 0; qq < 4; ++qq) { const int c = lane * 4 + 256 * qq; xv[qq] = *(const f32x4*)(X + (size_t)row * D + c); pv[qq] = *(const f32x4*)(prow + c); g4[qq] = *(const f32x4*)(gm + c); }
#pragma unroll
        for (int o = 1; o < 32; o <<= 1) q += __shfl_xor(q, o);
        const float rs = rstd_from(__shfl(q, 0)), rsp = rstd_from(__shfl(q, 32));
#pragma unroll
        for (int qq = 0; qq < 4; ++qq) {
            const int c = lane * 4 + 256 * qq;
            const f32x4 h = xv[qq] * g4[qq] * rs; f32x4 p = pv[qq];
            if (hasprev) p = p * g4[qq] * rsp; else if (prm) p = (f32x4){0.f, 0.f, 0.f, 0.f};
            *(u32x2*)(HX + (size_t)row * 2048 + c) = pk4(h); *(u32x2*)(HX + (size_t)row * 2048 + 1024 + c) = pk4(p - h);
            if (!prm) *(f32x4*)(a.out + O_SH_S + (size_t)(row - MP) * D + c) = h;
            else if (l == LSEQ - 1) *(f32x4*)(a.out + O_SH_P + (size_t)(row >> 11) * D + c) = h;
        }
    }
}

struct RwPrep { f32x4 nk, w, ka, kp, r; float bd; };
__device__ __forceinline__ RwPrep rw_prep(u32x2 rr, u32x2 rk, u32x2 rd, u32x2 ra, f32x4 kkc, f32x4 kac, f32x4 rkc) {
    RwPrep o; const f32x4 r = unpk4(rr), k = unpk4(rk), d = unpk4(rd), aa = unpk4(ra);
    const f32x4 kk = k * kkc; float ss = (kk[0] * kk[0] + kk[1] * kk[1]) + (kk[2] * kk[2] + kk[3] * kk[3]); ss = row16_sum(ss);
    const float inv = 1.f / fmaxf(sqrtf(ss), 1e-12f); const f32x4 kkn = kk * inv;
    o.nk = -kkn; o.ka = kkn * aa; o.kp = k * (1.f + (aa - 1.f) * kac); o.w = 1.f - d; o.r = r;
    const f32x4 t = r * o.kp * rkc; float bd = (t[0] + t[1]) + (t[2] + t[3]); o.bd = row16_sum(bd);
    return o;
}
__device__ __forceinline__ void rw4_phase(ArgsR a, LAS unsigned char* lds) {
    const int tid = otid(), il = tid >> 4, jl = tid & 15, tt = tid >> 4, c4 = (tid & 15) * 4;
    const bf16_t* Rg = WSB(WS_AR + AR_RKV); const bf16_t* Kg = Rg + RKV_PLANE / 2; const bf16_t* Vg = Rg + RKV_PLANE;
    const bf16_t* DEC = WSB(WS_AR + AR_DEC); const bf16_t* AA = WSB(WS_AR + AR_AA);
    bf16_t* ORAW = WSB(WS_XB); float* BD = WSF(WS_CAR);
    LAS float* L = (LAS float*)lds; constexpr int ARR = 2048;
    LAS float* OL = L + 12 * ARR; LAS float* BON = OL + 1024;
    for (int rep = 0; rep < (PROBE_RW4 ? 2 : 1); ++rep)
    for (int item = obid(); item < 256; item += gridDim.x) {
        const bool wr_ = rep == (PROBE_RW4 ? 1 : 0);
        const int half = item & 1, h = (item >> 1) & 15, b = item >> 5, irow = half * 32 + il;
        const f32x4 kkc = *(const f32x4*)(a.in[I_RWKK] + h * 64 + c4), kac = *(const f32x4*)(a.in[I_RWKA] + h * 64 + c4), rkc = *(const f32x4*)(a.in[I_RWRK] + h * 64 + c4);
        f32x4 S = {0.f, 0.f, 0.f, 0.f};
        size_t off = (size_t)(b * LSEQ + tt) * D + h * 64 + c4;
        u32x2 rr = *(const u32x2*)(Rg + off), rk = *(const u32x2*)(Kg + off), rv = *(const u32x2*)(Vg + off), rd = *(const u32x2*)(DEC + off), ra = *(const u32x2*)(AA + off);
        __syncthreads();
#pragma unroll 1
        for (int c = 0; c < LSEQ / 32; ++c) {
            const int bi = c & 1; LAS float* B = L + bi * 6 * ARR;
            { const RwPrep pp = rw_prep(rr, rk, rd, ra, kkc, kac, rkc); const int o = tt * 64 + c4;
              *(LAS f32x4*)(B + 0 * ARR + o) = pp.nk; *(LAS f32x4*)(B + 1 * ARR + o) = pp.w; *(LAS f32x4*)(B + 2 * ARR + o) = pp.ka; *(LAS f32x4*)(B + 3 * ARR + o) = pp.kp;
              *(LAS f32x4*)(B + 4 * ARR + o) = pp.r; *(LAS f32x4*)(B + 5 * ARR + o) = unpk4(rv); if (jl == 0) BON[bi * 32 + tt] = pp.bd; }
            __syncthreads();
            const int row0 = b * LSEQ + c * 32;
            if (c + 1 < LSEQ / 32) { off += (size_t)32 * D;
                rr = *(const u32x2*)(Rg + off); rk = *(const u32x2*)(Kg + off); rv = *(const u32x2*)(Vg + off); rd = *(const u32x2*)(DEC + off); ra = *(const u32x2*)(AA + off); }
            {
                const LAS float* Bj = B + jl * 4; const LAS float* Bv = B + 5 * ARR + irow;
                f32x4 nk = *(const LAS f32x4*)(Bj), ww = *(const LAS f32x4*)(Bj + ARR), ka = *(const LAS f32x4*)(Bj + 2 * ARR), kq = *(const LAS f32x4*)(Bj + 3 * ARR), rq = *(const LAS f32x4*)(Bj + 4 * ARR);
                float vv = Bv[0];
#pragma unroll 1
                for (int t4 = 0; t4 < 32; t4 += 4) {
                    float qs[4];
#pragma unroll
                    for (int u = 0; u < 4; ++u) {
                        const int tn = (t4 + u + 1) & 31;
                        const f32x4 nk2 = *(const LAS f32x4*)(Bj + tn * 64), ww2 = *(const LAS f32x4*)(Bj + ARR + tn * 64), ka2 = *(const LAS f32x4*)(Bj + 2 * ARR + tn * 64),
                                    kq2 = *(const LAS f32x4*)(Bj + 3 * ARR + tn * 64), rq2 = *(const LAS f32x4*)(Bj + 4 * ARR + tn * 64);
                        const float vv2 = Bv[tn * 64];
                        float p0 = S[0] * nk[0]; p0 = __builtin_fmaf(S[1], nk[1], p0); p0 = __builtin_fmaf(S[2], nk[2], p0); p0 = __builtin_fmaf(S[3], nk[3], p0);
                        p0 = row16_sum(p0);
                        S = S * ww + ka * p0 + kq * vv;
                        float q0 = S[0] * rq[0]; q0 = __builtin_fmaf(S[1], rq[1], q0); q0 = __builtin_fmaf(S[2], rq[2], q0); q0 = __builtin_fmaf(S[3], rq[3], q0);
                        qs[u] = row16_sum(q0);
                        nk = nk2; ww = ww2; ka = ka2; kq = kq2; rq = rq2; vv = vv2;
                    }
                    if (jl == 0) { OL[(t4 + 0) * 32 + il] = qs[0]; OL[(t4 + 1) * 32 + il] = qs[1]; OL[(t4 + 2) * 32 + il] = qs[2]; OL[(t4 + 3) * 32 + il] = qs[3]; }
                }
            }
            __syncthreads();
            if (wr_) { const f32x2 ov = *(const LAS f32x2*)(OL + tt * 32 + jl * 2);
                *(unsigned*)(ORAW + (size_t)(row0 + tt) * D + h * 64 + half * 32 + jl * 2) = pk2(ov.x, ov.y);
                if (half == 0 && tid < 32) BD[(size_t)(row0 + tid) * 16 + h] = BON[bi * 32 + tid]; }
        }
        if (wr_) *(f32x4*)(a.out + O_WKV_P + ((size_t)(b * 16 + h) * 64 + irow) * 64 + jl * 4) = S;
        __syncthreads();
    }
}
__device__ __forceinline__ void rw4b_phase(ArgsR a, LAS unsigned char* lds) {
    const int tid = otid(), rp = tid >> 4, jl = tid & 15, i0 = 2 * rp, i1 = i0 + 1;
    bf16_t* Rg = WSB(WS_AR + AR_RKV); const bf16_t* Kg = Rg + RKV_PLANE / 2; const bf16_t* Vg = Rg + RKV_PLANE;
    const bf16_t* DEC = WSB(WS_AR + AR_DEC); const bf16_t* AA = WSB(WS_AR + AR_AA); const bf16_t* GG = WSB(WS_AR + AR_GG);
    const bf16_t* ORAW = WSB(WS_XB); const float* BD = WSF(WS_CAR);
    LAS float* OL = (LAS float*)lds;
    {
        const int gt = obid() * NTHR + tid, NGT = gridDim.x * NTHR, c4 = jl * 4;
        for (int it = gt >> 4; it < MP * 16; it += 4 * (NGT >> 4)) {
            u32x2 ow[4], vw[4], gw[4]; float bd[4]; int itx[4];
#pragma unroll
            for (int u = 0; u < 4; ++u) { const int ii = it + u * (NGT >> 4); itx[u] = ii < MP * 16 ? ii : it; const size_t oo = (size_t)(itx[u] >> 4) * D + (itx[u] & 15) * 64 + c4;
                ow[u] = *(const u32x2*)(ORAW + oo); vw[u] = *(const u32x2*)(Vg + oo); gw[u] = *(const u32x2*)(GG + oo); bd[u] = BD[itx[u]]; }
#pragma unroll
            for (int u = 0; u < 4; ++u) { const int h = itx[u] & 15; const size_t oo = (size_t)(itx[u] >> 4) * D + h * 64 + c4;
                const f32x4 ov = unpk4(ow[u]), v4 = unpk4(vw[u]), g4 = unpk4(gw[u]);
                const f32x4 lnw = *(const f32x4*)(a.in[I_RWLNW] + h * 64 + c4), lnb = *(const f32x4*)(a.in[I_RWLNB] + h * 64 + c4);
                float sm = (ov[0] + ov[1]) + (ov[2] + ov[3]); sm = row16_sum(sm); const float mean = sm * (1.f / 64.f); const f32x4 dv = ov - mean;
                float vr = (dv[0] * dv[0] + dv[1] * dv[1]) + (dv[2] * dv[2] + dv[3] * dv[3]); vr = row16_sum(vr); const float rstd = 1.f / sqrtf(vr * (1.f / 64.f) + 64e-5f);
                const f32x4 res = (dv * rstd * lnw + lnb + v4 * bd[u]) * g4;
                if (u == 0 || it + u * (NGT >> 4) < MP * 16) *(u32x2*)(Rg + oo) = pk4(res); }
        }
    }
    __syncthreads();
    for (int item = obid(); item < 128 * 16; item += gridDim.x) {
        const int bs = item >> 4, h = item & 15, row = MP + bs; const size_t offj = (size_t)row * D + h * 64 + jl * 4;
        const f32x4 kkc = *(const f32x4*)(a.in[I_RWKK] + h * 64 + jl * 4), kac = *(const f32x4*)(a.in[I_RWKA] + h * 64 + jl * 4), rkc = *(const f32x4*)(a.in[I_RWRK] + h * 64 + jl * 4);
        const RwPrep pp = rw_prep(*(const u32x2*)(Rg + offj), *(const u32x2*)(Kg + offj), *(const u32x2*)(DEC + offj), *(const u32x2*)(AA + offj), kkc, kac, rkc);
        const float v0 = bf1(Vg[(size_t)row * D + h * 64 + i0]), v1 = bf1(Vg[(size_t)row * D + h * 64 + i1]);
        const size_t oo_ = (size_t)row * D + h * 64 + (tid & 15) * 4; const u32x2 vpre = *(const u32x2*)(Vg + oo_), gpre = *(const u32x2*)(GG + oo_);
        const size_t sidx = ((size_t)item * 64 + i0) * 64 + jl * 4;
        f32x4 S0 = *(const f32x4*)(a.in[I_WKV] + sidx), S1 = *(const f32x4*)(a.in[I_WKV] + sidx + 64);
        float p0 = (S0[0] * pp.nk[0] + S0[1] * pp.nk[1]) + (S0[2] * pp.nk[2] + S0[3] * pp.nk[3]), p1 = (S1[0] * pp.nk[0] + S1[1] * pp.nk[1]) + (S1[2] * pp.nk[2] + S1[3] * pp.nk[3]);
        p0 = row16_sum(p0); p1 = row16_sum(p1);
        S0 = S0 * pp.w + pp.ka * p0 + pp.kp * v0; S1 = S1 * pp.w + pp.ka * p1 + pp.kp * v1;
        *(f32x4*)(a.out + O_WKV_S + sidx) = S0; *(f32x4*)(a.out + O_WKV_S + sidx + 64) = S1;
        float q0 = (S0[0] * pp.r[0] + S0[1] * pp.r[1]) + (S0[2] * pp.r[2] + S0[3] * pp.r[3]), q1 = (S1[0] * pp.r[0] + S1[1] * pp.r[1]) + (S1[2] * pp.r[2] + S1[3] * pp.r[3]);
        q0 = row16_sum(q0); q1 = row16_sum(q1);
        if (jl == 0) { OL[i0] = q0; OL[i1] = q1; }
        __syncthreads();
        if (tid < 16) { const int cc = tid * 4; const size_t oo = (size_t)row * D + h * 64 + cc;
            const f32x4 ov = *(const LAS f32x4*)(OL + cc), v4 = unpk4(vpre), g4 = unpk4(gpre);
            const f32x4 lnw = *(const f32x4*)(a.in[I_RWLNW] + h * 64 + cc), lnb = *(const f32x4*)(a.in[I_RWLNB] + h * 64 + cc);
            float sm = (ov[0] + ov[1]) + (ov[2] + ov[3]); sm = row16_sum(sm); const float mean = sm * (1.f / 64.f); const f32x4 dv = ov - mean;
            float vr = (dv[0] * dv[0] + dv[1] * dv[1]) + (dv[2] * dv[2] + dv[3] * dv[3]); vr = row16_sum(vr); const float rstd = 1.f / sqrtf(vr * (1.f / 64.f) + 64e-5f);
            const f32x4 res = (dv * rstd * lnw + lnb + v4 * pp.bd) * g4; *(u32x2*)(Rg + oo) = pk4(res); }
        __syncthreads();
    }
}

__device__ __forceinline__ void lru_conv_phase(ArgsR a) {
    const int gt = obid() * NTHR + otid(), NGT = gridDim.x * NTHR;
    const bf16_t* UPRE = WSB(WS_AR + AR_UPRE); bf16_t* U = WSB(WS_AR + AR_U); const float* cw = a.in[I_LCW]; const float* cb = a.in[I_LCB];
    for (int it = gt; it < (MP / 4) * 128; it += NGT) {
        const int row0 = (it >> 7) * 4, c = (it & 127) * 8, l0 = row0 & (LSEQ - 1);
        u32x4 g[7]; const u32x4 z = {0, 0, 0, 0};
#pragma unroll
        for (int r = 0; r < 3; ++r) g[r] = l0 ? *(const u32x4*)(UPRE + (size_t)(row0 - 3 + r) * D + c) : z;
#pragma unroll
        for (int r = 0; r < 4; ++r) g[3 + r] = *(const u32x4*)(UPRE + (size_t)(row0 + r) * D + c);
        float w[4][8], bb[8], x[7][8];
#pragma unroll
        for (int e = 0; e < 8; ++e) { bb[e] = cb[c + e];
#pragma unroll
            for (int k = 0; k < 4; ++k) w[k][e] = cw[k * D + c + e]; }
#pragma unroll
        for (int r = 0; r < 7; ++r) unpk8(g[r], x[r]);
#pragma unroll
        for (int r = 0; r < 4; ++r) { float o[8];
#pragma unroll
            for (int e = 0; e < 8; ++e) o[e] = bb[e] + x[r][e] * w[0][e] + x[r + 1][e] * w[1][e] + x[r + 2][e] * w[2][e] + x[r + 3][e] * w[3][e];
            u32x4 ov; ov.x = pk2(o[0], o[1]); ov.y = pk2(o[2], o[3]); ov.z = pk2(o[4], o[5]); ov.w = pk2(o[6], o[7]);
            *(u32x4*)(U + (size_t)(row0 + r) * D + c) = ov; }
        if (l0 == LSEQ - 4) { float* o = a.out + O_LC_P + ((size_t)(row0 >> 11) * 3) * D + c;
#pragma unroll
            for (int e = 0; e < 8; ++e) { o[e] = x[4][e]; o[D + e] = x[5][e]; o[2 * D + e] = x[6][e]; } }
    }
    for (int it = gt; it < MS * 256; it += NGT) {
        const int bs = it >> 8, c = (it & 255) * 4, row = MP + bs; f32x4 x[4];
        x[3] = unpk4(*(const u32x2*)(UPRE + (size_t)row * D + c));
        const float* st = a.in[I_LC] + (size_t)bs * 3 * D + c; float* o = a.out + O_LC_S + (size_t)bs * 3 * D + c;
#pragma unroll
        for (int k = 0; k < 3; ++k) x[k] = *(const f32x4*)(st + k * D);
        *(f32x4*)o = x[1]; *(f32x4*)(o + D) = x[2]; *(f32x4*)(o + 2 * D) = x[3];
        f32x4 r = *(const f32x4*)(cb + c);
#pragma unroll
        for (int k = 0; k < 4; ++k) r += x[k] * *(const f32x4*)(cw + k * D + c);
        *(u32x2*)(U + (size_t)row * D + c) = pk4(r);
    }
}
__device__ __forceinline__ void lru_scan1_phase(ArgsR a, bool st = true) {
    const int gt = obid() * NTHR + otid(), NGT = gridDim.x * NTHR; constexpr int NIT = 8 * 32 * 1024;
    const float* AF = WSF(WS_AR + AR_AF); const bf16_t* BX = WSB(WS_AR + AR_BX); bf16_t* GATE = WSB(WS_AR + AR_GATE); float* CAR = WSF(WS_CAR);
    for (int id = gt; id < NIT; id += 2 * NGT) {
        const int id1 = id + NGT < NIT ? id + NGT : id; size_t o[2]; float ap[2] = {1.f, 1.f}, h[2] = {0.f, 0.f};
        o[0] = (size_t)((id >> 15) * LSEQ + ((id >> 10) & 31) * 64) * D + (id & 1023); o[1] = (size_t)((id1 >> 15) * LSEQ + ((id1 >> 10) & 31) * 64) * D + (id1 & 1023);
#pragma unroll 1
        for (int t0 = 0; t0 < 64; t0 += 8) { float av[2][8], bv[2][8];
#pragma unroll
            for (int u = 0; u < 2; ++u)
#pragma unroll
                for (int t = 0; t < 8; ++t) { av[u][t] = AF[o[u] + (size_t)t * D]; bv[u][t] = bf1(BX[o[u] + (size_t)t * D]); }
#pragma unroll
            for (int u = 0; u < 2; ++u) {
#pragma unroll
                for (int t = 0; t < 8; ++t) { h[u] = av[u][t] * h[u] + bv[u][t]; ap[u] *= av[u][t]; }
                o[u] += (size_t)8 * D; } }
        *(f32x2*)(CAR + (size_t)id * 2) = (f32x2){ap[0], h[0]}; if (id1 != id) *(f32x2*)(CAR + (size_t)id1 * 2) = (f32x2){ap[1], h[1]};
    }
    if (st)
    for (int id = gt; id < MS * 1024; id += NGT) {
        const int ch = id & 1023, bs = id >> 10; const size_t o = (size_t)(MP + bs) * D + ch;
        const float h = AF[o] * a.in[I_LH][id] + bf1(BX[o]); a.out[O_LH_S + id] = h; GATE[o] = (bf16_t)f2bf(h * bf1(GATE[o]));
    }
}
__device__ __forceinline__ void lru_scan2_phase(ArgsR a, bool st = true) {
    const int gt = obid() * NTHR + otid(), NGT = gridDim.x * NTHR; constexpr int NIT = 8 * 32 * 1024;
    const float* AF = WSF(WS_AR + AR_AF); const bf16_t* BX = WSB(WS_AR + AR_BX); bf16_t* GATE = WSB(WS_AR + AR_GATE); const float* CAR = WSF(WS_CAR);
    (void)st;
    for (int id = gt; id < NIT; id += 2 * NGT) {
        const int id1 = id + NGT < NIT ? id + NGT : id; int idv[2] = {id, id1}; float h[2]; size_t o[2];
#pragma unroll
        for (int u = 0; u < 2; ++u) {
            const int ch = idv[u] & 1023, ck = (idv[u] >> 10) & 31, b = idv[u] >> 15; f32x2 cv[31];
#pragma unroll
            for (int c2 = 0; c2 < 31; ++c2) cv[c2] = *(const f32x2*)(CAR + ((size_t)(b * 32 + c2) * 1024 + ch) * 2);
            float hh = 0.f;
#pragma unroll
            for (int c2 = 0; c2 < 31; ++c2) hh = c2 < ck ? cv[c2].x * hh + cv[c2].y : hh;
            h[u] = hh; o[u] = (size_t)(b * LSEQ + ck * 64) * D + ch;
        }
#pragma unroll 1
        for (int t0 = 0; t0 < 64; t0 += 8) { float av[2][8], bv[2][8], gv[2][8];
#pragma unroll
            for (int u = 0; u < 2; ++u)
#pragma unroll
                for (int t = 0; t < 8; ++t) { av[u][t] = AF[o[u] + (size_t)t * D]; bv[u][t] = bf1(BX[o[u] + (size_t)t * D]); gv[u][t] = bf1(GATE[o[u] + (size_t)t * D]); }
#pragma unroll
            for (int u = 0; u < 2; ++u) { if (u == 1 && id1 == id) break;
#pragma unroll
                for (int t = 0; t < 8; ++t) { h[u] = av[u][t] * h[u] + bv[u][t]; GATE[o[u] + (size_t)t * D] = (bf16_t)f2bf(h[u] * gv[u][t]); }
                o[u] += (size_t)8 * D; } }
#pragma unroll
        for (int u = 0; u < 2; ++u) if (((idv[u] >> 10) & 31) == 31 && (u == 0 || id1 != id)) a.out[O_LH_P + (idv[u] >> 15) * 1024 + (idv[u] & 1023)] = h[u];
    }
}
__device__ __forceinline__ void lru_scan_fused(ArgsR a, LAS unsigned char* lds) {
    const int tid = otid(), ck = tid >> 4, cl = tid & 15;
    const float* AF = WSF(WS_AR + AR_AF); const bf16_t* BX = WSB(WS_AR + AR_BX); bf16_t* GATE = WSB(WS_AR + AR_GATE);
    LAS f32x4* car = (LAS f32x4*)lds;
    for (int item = obid(); item < 256; item += gridDim.x) {
        const int b = item >> 5, ch0 = (item & 31) * 32 + cl * 2; const size_t o0 = (size_t)(b * LSEQ + ck * 64) * D + ch0;
        float ap0 = 1.f, ap1 = 1.f, h0 = 0.f, h1 = 0.f; size_t o = o0;
#pragma unroll 1
        for (int t0 = 0; t0 < 64; t0 += 8) { f32x2 av[8]; unsigned bv[8];
#pragma unroll
            for (int t = 0; t < 8; ++t) { av[t] = *(const f32x2*)(AF + o + (size_t)t * D); bv[t] = *(const unsigned*)(BX + o + (size_t)t * D); }
#pragma unroll
            for (int t = 0; t < 8; ++t) { h0 = av[t].x * h0 + bflo(bv[t]); h1 = av[t].y * h1 + bfhi(bv[t]); ap0 *= av[t].x; ap1 *= av[t].y; }
            o += (size_t)8 * D; }
        __syncthreads();
        car[ck * 16 + cl] = (f32x4){ap0, h0, ap1, h1};
        __syncthreads();
        h0 = 0.f; h1 = 0.f;
        for (int c2 = 0; c2 < ck; ++c2) { const f32x4 cv = car[c2 * 16 + cl]; h0 = cv[0] * h0 + cv[1]; h1 = cv[2] * h1 + cv[3]; }
        o = o0;
#pragma unroll 1
        for (int t0 = 0; t0 < 64; t0 += 8) { f32x2 av[8]; unsigned bv[8], gv[8];
#pragma unroll
            for (int t = 0; t < 8; ++t) { av[t] = *(const f32x2*)(AF + o + (size_t)t * D); bv[t] = *(const unsigned*)(BX + o + (size_t)t * D); gv[t] = *(const unsigned*)(GATE + o + (size_t)t * D); }
#pragma unroll
            for (int t = 0; t < 8; ++t) { h0 = av[t].x * h0 + bflo(bv[t]); h1 = av[t].y * h1 + bfhi(bv[t]); *(unsigned*)(GATE + o + (size_t)t * D) = pk2(h0 * bflo(gv[t]), h1 * bfhi(gv[t])); }
            o += (size_t)8 * D; }
        if (ck == 31) { a.out[O_LH_P + b * 1024 + ch0] = h0; a.out[O_LH_P + b * 1024 + ch0 + 1] = h1; }
    }
    __syncthreads();
    const int gt = obid() * NTHR + tid, NGT = gridDim.x * NTHR;
    for (int id = gt; id < MS * 1024; id += NGT) {
        const int ch = id & 1023, bs = id >> 10; const size_t o = (size_t)(MP + bs) * D + ch;
        const float h = AF[o] * a.in[I_LH][id] + bf1(BX[o]); a.out[O_LH_S + id] = h; GATE[o] = (bf16_t)f2bf(h * bf1(GATE[o]));
    }
}
__device__ __forceinline__ void final_phase(ArgsR a, bool st = true) {
    const int tid = otid(), lane = tid & 63, wave = tid >> 6, gw = obid() * 8 + wave, NGW = gridDim.x * 8;
    const float* SSQ = WSF(WS_SSQ); const float* gm = a.in[I_NFIN];
    (void)st;
    for (int row = gw; row < MA; row += 2 * NGW) {
        const int row2 = row + NGW; const bool has2 = row2 < MA; const int r2 = has2 ? row2 : row;
        float q = SSQ[(size_t)(lane < 32 ? row : r2) * 32 + (lane & 31)]; f32x4 xa[4], xb[4];
#pragma unroll
        for (int qq = 0; qq < 4; ++qq) { xa[qq] = *(const f32x4*)(a.out + (size_t)row * D + lane * 4 + 256 * qq); xb[qq] = *(const f32x4*)(a.out + (size_t)r2 * D + lane * 4 + 256 * qq); }
#pragma unroll
        for (int o = 1; o < 32; o <<= 1) q += __shfl_xor(q, o);
        const float rs1 = rstd_from(__shfl(q, 0)), rs2 = rstd_from(__shfl(q, 32));
#pragma unroll
        for (int qq = 0; qq < 4; ++qq) { const int c = lane * 4 + 256 * qq; const f32x4 g4 = *(const f32x4*)(gm + c);
            *(f32x4*)(a.out + (size_t)row * D + c) = xa[qq] * g4 * rs1; if (has2) *(f32x4*)(a.out + (size_t)row2 * D + c) = xb[qq] * g4 * rs2; }
    }
}


#define XB_TMO      128
#define XB_XCNT(j)  (256  + 64 * (j))
#define XB_XSUB(j)  (1280 + 64 * (j))
#define XB_XGEN(j)  (2304 + 64 * (j))
#define XB_TOP      3328
#define XB_TOPGEN   3392
#define XCD_BAR_WORDS 3456
#define XB_SPIN_CAP (1u << 18)
__device__ __forceinline__ unsigned xb_ld(unsigned* p)              { return __hip_atomic_load(p, __ATOMIC_RELAXED, __HIP_MEMORY_SCOPE_AGENT); }
__device__ __forceinline__ unsigned xb_add(unsigned* p, unsigned v) { return __hip_atomic_fetch_add(p, v, __ATOMIC_RELAXED, __HIP_MEMORY_SCOPE_AGENT); }
__device__ __forceinline__ unsigned xb_xcc_id() { return (unsigned)__builtin_amdgcn_s_getreg((3 << 11) | 20) & 0xFu; }
#define XB_SPIN(cond, bar) do { unsigned _sp = 0; while (cond) { \
    if ((++_sp & 255u) == 0u) { if (xb_ld(&(bar)[XB_TMO])) break; if (_sp > XB_SPIN_CAP) { atomicAdd(&(bar)[XB_TMO], 1u); break; } } } } while (0)
struct XcdBarrier { unsigned* bar; unsigned x; volatile LAS unsigned* st; };
__device__ __forceinline__ XcdBarrier xcd_barrier_post(unsigned* bar, volatile LAS unsigned* st) {
    XcdBarrier b; b.bar = bar; b.x = xb_xcc_id(); b.st = st;
    if (threadIdx.x == 0) (void)xb_add(&bar[XB_XCNT(b.x)], 1u);
    return b;
}
__device__ __forceinline__ void xcd_barrier_complete(unsigned* bar, unsigned x, unsigned& nloc, unsigned& nx) {
    const unsigned G = gridDim.x * gridDim.y * gridDim.z;
    unsigned sum, cnt, mine, sp = 0u;
    for (;;) {
        sum = 0u; cnt = 0u; mine = 0u;
#pragma unroll
        for (unsigned j = 0; j < 16; ++j) { const unsigned c = xb_ld(&bar[XB_XCNT(j)]); sum += c; cnt += (c > 0u) ? 1u : 0u; mine = (j == x) ? c : mine; }
        if (sum == G) break;
        __builtin_amdgcn_s_sleep(1);
        if ((++sp & 255u) == 0u) { if (xb_ld(&bar[XB_TMO])) break; if (sp > XB_SPIN_CAP) { atomicAdd(&bar[XB_TMO], 1u); break; } }
    }
    nloc = mine > 0u ? mine : 1u; nx = cnt > 0u ? cnt : 1u;
}
__device__ __forceinline__ void xcd_barrier(const XcdBarrier& b) {
    asm volatile("s_waitcnt vmcnt(0)" ::: "memory");
    __syncthreads();
    if (threadIdx.x == 0) {
        unsigned* bar = b.bar;
        __builtin_amdgcn_s_waitcnt(0);
        unsigned nloc = b.st[0], nx = b.st[1];
        if (nloc == 0u) { xcd_barrier_complete(bar, b.x, nloc, nx); b.st[0] = nloc; b.st[1] = nx; }
        const unsigned old = xb_add(&bar[XB_XSUB(b.x)], 1u);
        const unsigned gen = old / nloc;
        if (old + 1u == (gen + 1u) * nloc) {
            __builtin_amdgcn_fence(__ATOMIC_RELEASE, "agent");
            asm volatile("s_waitcnt vmcnt(0)" ::: "memory");
            const unsigned og = xb_add(&bar[XB_TOP], 1u);
            const unsigned tg = og / nx;
            if (og + 1u == (tg + 1u) * nx) xb_add(&bar[XB_TOPGEN], 1u);
            else XB_SPIN(xb_ld(&bar[XB_TOPGEN]) == tg, bar);
            __builtin_amdgcn_fence(__ATOMIC_ACQUIRE, "agent");
            xb_add(&bar[XB_XGEN(b.x)], 1u);
            asm volatile("s_waitcnt vmcnt(0)" ::: "memory");
        } else {
            XB_SPIN(xb_ld(&bar[XB_XGEN(b.x)]) == gen, bar);
            __builtin_amdgcn_fence(__ATOMIC_ACQUIRE, "agent");
            asm volatile("s_waitcnt vmcnt(0)" ::: "memory");
        }
    }
    __syncthreads();
}


__device__ __forceinline__ void ffn_fix(ArgsR a, int li) {
    const int tid = otid(); pg8::StaticOrder S; S.init(64, 4, (int)gridDim.x, obid()); pg8::Unit u;
    bf16_t* ACT = WSB(WS_AR + AR_UP); const float* HALO = WSF(WS_AR + AR_G); const float* GFIX = HALO + 64 * 2 * FF; const float* UPFIX = GFIX + 64 * 2 * FF;
    const float* cw = a.in[I_FCW] + (size_t)li * 3 * FF; const float* cb = a.in[I_FCB] + (size_t)li * FF;
    for (int i = 0; S.next(i, u); ++i) {
        const int pm = u.pm; if ((pm & 7) == 0) continue;
        for (int cg = tid; cg < FF / 4; cg += NTHR) {
            const int col = cg * 4;
            const f32x4 gm2 = *(const f32x4*)(HALO + (size_t)((pm - 1) * 2) * FF + col), gm1 = *(const f32x4*)(HALO + (size_t)((pm - 1) * 2 + 1) * FF + col);
            const f32x4 g0 = *(const f32x4*)(GFIX + (size_t)(pm * 2) * FF + col), g1 = *(const f32x4*)(GFIX + (size_t)(pm * 2 + 1) * FF + col);
            const f32x4 u0 = *(const f32x4*)(UPFIX + (size_t)(pm * 2) * FF + col), u1 = *(const f32x4*)(UPFIX + (size_t)(pm * 2 + 1) * FF + col);
            const f32x4 bb = *(const f32x4*)(cb + col), w0 = *(const f32x4*)(cw + col), w1 = *(const f32x4*)(cw + FF + col), w2 = *(const f32x4*)(cw + 2 * FF + col);
            const f32x4 c0 = bb + gm2 * w0 + gm1 * w1 + g0 * w2, c1 = bb + gm1 * w0 + g0 * w1 + g1 * w2; f32x4 o0, o1;
#pragma unroll
            for (int e = 0; e < 4; ++e) { o0[e] = c0[e] * sigmoidf_(c0[e]) * u0[e]; o1[e] = c1[e] * sigmoidf_(c1[e]) * u1[e]; }
            *(u32x2*)(ACT + (size_t)(pm * 256) * FF + col) = pk4(o0); *(u32x2*)(ACT + (size_t)(pm * 256 + 1) * FF + col) = pk4(o1);
        }
    }
    asm volatile("s_waitcnt vmcnt(0)" ::: "memory");
    __syncthreads();
}

#define A2 WSB(WS_AR + AR_A2)
#define YB WSB(WS_AR + AR_YB)
#define HX WSB(WS_AR + AR_HX)
#define RKV WSB(WS_AR + AR_RKV)
#define LORA WSB(WS_AR + AR_LORA)
#define GATE WSB(WS_AR + AR_GATE)
#define UPRE WSB(WS_AR + AR_UPRE)
#define U_ WSB(WS_AR + AR_U)
#define G_ WSB(WS_AR + AR_G)
#define UP_ WSB(WS_AR + AR_UP)
constexpr int LDS_BYTES = 147456;
constexpr int NPHASES = 31;
constexpr int BIG = 1 << 30;

struct EpiNull {
    static constexpr bool IDEMP = false;
    __device__ __forceinline__ void operator()(const f32x4 (&acc)[2][2][4][2], const pg8::Unit&, int, int, int, int) const {
#pragma unroll
        for (int a = 0; a < 2; ++a)
#pragma unroll
            for (int b = 0; b < 2; ++b)
#pragma unroll
                for (int m = 0; m < 4; ++m)
#pragma unroll
                    for (int n = 0; n < 2; ++n) asm volatile("" :: "v"(acc[a][b][m][n]));
    }
};
template <class F>
__device__ __forceinline__ void run_gemm(LAS unsigned char* lds, const pg8::Gemm& g, const F& f, const float* ssq_in, float* ssq_out) {
    pg8::StaticOrder S; S.init(g.nM, g.nN, (int)gridDim.x, obid());
    EpiWrap<F> E{f, ssq_in, ssq_out};
    if (PROBE_GEMM2) { EpiNull N; pg8::gemm_phase<EpiNull>(lds, g, S, N); }
    pg8::gemm_phase<EpiWrap<F>>(lds, g, S, E);
}

__global__ void __launch_bounds__(NTHR, 2) mega(Args a0) {
    extern __shared__ __attribute__((aligned(16))) unsigned char lds_raw[];
    LAS unsigned char* lds = (LAS unsigned char*)lds_raw;
    cg::grid_group grid = cg::this_grid();
    volatile LAS unsigned* misc = (volatile LAS unsigned*)(lds + 131072 + 320);
    if (threadIdx.x < 32) misc[threadIdx.x] = 0u;
    __syncthreads();
    XcdBarrier xbar = xcd_barrier_post((unsigned*)(a0.ws + WS_CTL), misc + 8);
    int k = 0; const int plo = a0.lo, phi = a0.hi;
#define PH(...) do { if (k >= plo && k < phi) { ArgsR a = *opaque_args(); float* X = a.out; bf16_t* XB = WSB(WS_XB); float* SSQ = WSF(WS_SSQ); (void)X; (void)XB; (void)SSQ; __VA_ARGS__; if (k + 1 < phi) { if (phi > NPHASES) grid.sync(); else xcd_barrier(xbar); if (PROBE_SYNC2) xcd_barrier(xbar); } } ++k; } while (0)
    PH( prologue_weights(a, lds); if (PROBE_PRO2) { __syncthreads(); prologue_weights(a, lds); } s5_gen(a, lds, 0); if (PROBE_GEN2) s5_gen(a, lds, 0); );
#pragma nounroll
    for (int li = 0; li < 4; ++li) {
        const int kind = li % 3, j = li / 3;
        if (kind == 0) {
            PH( s5_u_phase(a, li, j); if (PROBE_EW2) s5_u_phase(a, li, j); );
            PH( REP(4) { pg8::Gemm g{A2, WSB(WS_AR + AR_S5A), 384, 256, 256, 256, 1, BIG, 0, 4, 65536}; run_gemm(lds, g, F_S5A{WSF(WS_AR + AR_HLOC)}, nullptr, nullptr); } );
            PH( s5_carry_phase(a, j); if (PROBE_EW2) s5_carry_phase(a, j); );
            PH( REP(4) { pg8::Gemm g{A2, WSB(WS_AR + AR_S5C), 384, 384, 384, 256, 1, BIG, 0, 4, 98304}; run_gemm(lds, g, F_S5C{A2, a.in[I_S5D] + j * 1024, YB}, nullptr, nullptr); } );
            PH( REP(32) { const bf16_t* W = WSB(WS_WGLU) + (size_t)j * 2048 * 1024; pg8::Gemm g{YB, W, 1024, 1024, 1024, 64, 8, BIG, 0, BIG, 0}; F_GLU f{X, XB, (PROBE_PH & 32) && rp_ == 0, li == 0 ? a.in[I_XP] : X, li == 0 ? a.in[I_XS] : X + (size_t)MP * D};
                  run_gemm(lds, g, f, nullptr, SSQ); sample_gemm(lds, YB + (size_t)MP * D, 1024, W, 1024, 32, 1024, MP, f, nullptr, SSQ); } );
        } else if (kind == 1) {
            PH( rw1_phase(a, li); if (PROBE_EW2) rw1_phase(a, li); );
            PH( REP(2) { pg8::Gemm g{HX, WSB(WS_WRW2), 2048, 2048, 2048, 64, 13, BIG, 0, BIG, 0}; F_RW2 f{RKV, LORA};
                  run_gemm(lds, g, f, nullptr, nullptr); sample_gemm(lds, HX + (size_t)MP * 2048, 2048, WSB(WS_WRW2), 2048, 104, 2048, MP, f, nullptr, nullptr, BIG, 0, 832 % (int)gridDim.x);
                  if (rp_ == 0) { const int w0 = 832 % (int)gridDim.x; if (obid() >= w0) convert_items(a, lds, (obid() - w0) * 8 + (otid() >> 6), ((int)gridDim.x - w0) * 8, 1); } } );
            PH( REP(2) { pg8::Gemm g{LORA, WSB(WS_WRW3), 256, 256, 256, 64, 12, BIG, 0, BIG, 0}; F_RW3 f{a.in[I_RWW0], a.in[I_RWA0], WSB(WS_AR + AR_DEC), WSB(WS_AR + AR_AA), WSB(WS_AR + AR_GG)};
                  run_gemm(lds, g, f, nullptr, nullptr); sample_gemm(lds, LORA + (size_t)MP * 256, 256, WSB(WS_WRW3), 256, 96, 256, MP, f, nullptr, nullptr); } );
            PH( rw4_phase(a, lds); );
            PH( rw4b_phase(a, lds); );
            PH( REP(32) { pg8::Gemm g{RKV, WSB(WS_WRWO), 1024, 1024, 1024, 64, 4, BIG, 0, BIG, 0}; F_RES f{X, XB, (PROBE_PH & 32) && rp_ == 0};
                  run_gemm(lds, g, f, nullptr, SSQ); sample_gemm(lds, RKV + (size_t)MP * D, 1024, WSB(WS_WRWO), 1024, 32, 1024, MP, f, nullptr, SSQ); } );
        } else {
            PH( REP(8) { pg8::Gemm g{XB, WSB(WS_WLIN), 1024, 1024, 1024, 64, 8, BIG, 0, BIG, 0}; F_LRUIN f{GATE, UPRE};
                  run_gemm(lds, g, f, SSQ, nullptr); sample_gemm(lds, XB + (size_t)MP * D, 1024, WSB(WS_WLIN), 1024, 32, 1024, MP, f, SSQ, nullptr); } );
            PH( lru_conv_phase(a); if (PROBE_EW2) lru_conv_phase(a); );
            PH( REP(8) { pg8::Gemm g{U_, WSB(WS_WRGIG), 1024, 256, 256, 64, 8, 2, 256, BIG, 0}; F_RGIG f{a.in[I_LBRG], a.in[I_LBIG], WSF(WS_LSL), U_, WSF(WS_AR + AR_AF), WSB(WS_AR + AR_BX)};
                  run_gemm(lds, g, f, nullptr, nullptr); sample_gemm(lds, U_ + (size_t)MP * D, 1024, WSB(WS_WRGIG), 256, 32, 256, MP, f, nullptr, nullptr, 8, 256); } );
            PH( lru_scan_fused(a, lds); );
            PH( REP(32) { pg8::Gemm g{GATE, WSB(WS_WLOUT), 1024, 1024, 1024, 64, 4, BIG, 0, BIG, 0}; F_RES f{X, XB, (PROBE_PH & 32) && rp_ == 0};
                  run_gemm(lds, g, f, nullptr, SSQ); sample_gemm(lds, GATE + (size_t)MP * D, 1024, WSB(WS_WLOUT), 1024, 32, 1024, MP, f, nullptr, SSQ); } );
        }
        PH( REP(1) { const bf16_t* W = WSB(WS_WFIN) + (size_t)li * 5632 * 1024; pg8::Gemm g{XB, W, 1024, 1024, 1024, 64, 22, BIG, 0, BIG, 0};
              const float* cw = a.in[I_FCW] + (size_t)li * 3 * FF; const float* cb = a.in[I_FCB] + (size_t)li * FF; float* HALO = WSF(WS_AR + AR_G);
              { pg8::StaticOrder S; S.init(64, 22, (int)gridDim.x, obid());
                EpiFFN E{UP_, HALO, HALO + 64 * 2 * FF, HALO + 2 * 64 * 2 * FF, SSQ, cw, cb, a.out + O_FC_P + (size_t)li * 8 * 2 * FF, (LAS float*)(lds + 131072 + 1024)};
                pg8::gemm_phase<EpiFFN>(lds, g, S, E); }
              F_FFNIN_S fs{UP_, a.in[I_FC] + (size_t)li * 128 * 2 * FF, a.out + O_FC_S + (size_t)li * 128 * 2 * FF, cw, cb};
              sample_gemm(lds, XB + (size_t)MP * D, 1024, W, 1024, 88, 1024, MP, fs, SSQ, nullptr, BIG, 0, 1408 % (int)gridDim.x);
              if (li == 2) s5_gen(a, lds, 1); } );
        PH( REP(16) { const bf16_t* W = WSB(WS_WFOUT) + (size_t)li * 1024 * 2816; pg8::Gemm g{UP_, W, 2816, 2816, 2816, 64, 4, BIG, 0, BIG, 0}; F_RES f{X, XB, (PROBE_PH & 16) && rp_ == 0};
              ffn_fix(a, li);
              run_gemm(lds, g, f, nullptr, SSQ); sample_gemm(lds, UP_ + (size_t)MP * FF, 2816, W, 2816, 32, 2816, MP, f, nullptr, SSQ); } );
    }
    PH( final_phase(a); );
#undef PH
}

extern "C" void kernel_launch(void* const* d_in, const int* in_sizes, int n_in, void* d_out, int out_size, void* d_ws, size_t ws_size, hipStream_t stream) {
    static int grid = 0;
    if (grid == 0) {
        if (n_in != 50 || (size_t)out_size != O_END || ws_size < WS_END) {
            fprintf(stderr, "kernel_launch: unexpected shapes: n_in %d out %d ws %zu (need %zu)\n", n_in, out_size, ws_size, (size_t)WS_END); grid = -1; return; }
        int dev = 0, cus = 0, per_cu = 0;
        hipGetDevice(&dev); hipDeviceGetAttribute(&cus, hipDeviceAttributeMultiprocessorCount, dev);
        if (hipFuncSetAttribute((const void*)mega, hipFuncAttributeMaxDynamicSharedMemorySize, LDS_BYTES) != hipSuccess) { fprintf(stderr, "kernel_launch: hipFuncSetAttribute failed\n"); grid = -1; return; }
        if (hipOccupancyMaxActiveBlocksPerMultiprocessor(&per_cu, (const void*)mega, NTHR, LDS_BYTES) != hipSuccess || per_cu < 1) { fprintf(stderr, "kernel_launch: occupancy query says %d\n", per_cu); per_cu = 1; }
        (void)hipGetLastError();
        grid = cus * per_cu;
        fprintf(stderr, "kernel_launch: grid %d (cus %d x %d)\n", grid, cus, per_cu);
    }
    if (grid < 0) return;
    Args a{};
    for (int i = 0; i < 50; ++i) a.in[i] = (const float*)d_in[i];
    a.out = (float*)d_out; a.ws = (unsigned char*)d_ws;
#if PER_PHASE_LAUNCH
    for (int k = 0; k < NPHASES; ++k) { a.lo = k; a.hi = k + 1; hipLaunchKernelGGL(mega, dim3(grid), dim3(NTHR), LDS_BYTES, stream, a); }
#else
    if (hipMemsetAsync((char*)d_ws + WS_CTL, 0, XCD_BAR_WORDS * 4, stream) != hipSuccess) { fprintf(stderr, "kernel_launch: memset failed\n"); return; }
    a.lo = 0; a.hi = NPHASES; void* args[] = {&a};
    hipError_t e = hipLaunchCooperativeKernel((const void*)mega, dim3(grid), dim3(NTHR), args, LDS_BYTES, stream);
    if (e != hipSuccess) fprintf(stderr, "cooperative launch failed: %s (grid %d)\n", hipGetErrorString(e), grid);
#endif
}
```
